# Optimizing an MI355X kernel written in HIP

```python
import jax, jax.numpy as jnp
from jax import lax
import numpy as np

D_MODEL = 2048
BATCH = 16
SEQ = 2048
DEPTH = 4

D_MIX = D_MODEL
D_CONV = D_MIX // 2
D_HGRN = D_MIX - D_CONV
CONV_GROUPS = 8
CONV_GROUP_DIM = D_CONV // CONV_GROUPS
CONV_WIDTH = 3
HGRN_HEADS = 8
HGRN_KEY_DIM = D_HGRN // HGRN_HEADS
HGRN_VAL_DIM = D_HGRN // HGRN_HEADS
CHUNK = 64
D_IN = 3 * D_CONV + 4 * D_HGRN
D_FF = -(-8 * D_MODEL // (3 * 256)) * 256
EPS = 1e-6
MIN_FORGET = 1e-30

kernel_name = "hybrid_conv_hgrn2_parallel_trunk"


def rms_norm(x, gain):
    xf = x.astype(jnp.float32)
    y = xf * lax.rsqrt(jnp.mean(xf * xf, axis=-1, keepdims=True) + EPS)
    return (y * gain.astype(jnp.float32)).astype(x.dtype)


def short_conv_mixer(gate_b, gate_c, h, conv_w, gn):
    bsz, length, _ = h.shape
    u = gate_c * h
    up = jnp.pad(u, ((0, 0), (CONV_WIDTH - 1, 0), (0, 0)))
    y = up[:, 0:length] * conv_w[0]
    for j in range(1, CONV_WIDTH):
        y = y + up[:, j:j + length] * conv_w[j]
    y = gate_b * y
    y = rms_norm(y.reshape(bsz, length, CONV_GROUPS, CONV_GROUP_DIM),
                 gn.reshape(CONV_GROUPS, CONV_GROUP_DIM))
    return y.reshape(bsz, length, D_CONV)


def hgrn2_mixer(q, z, v, g, lb, gn):
    bsz, length, _ = q.shape
    n_chunks = length // CHUNK
    out_dtype = v.dtype
    qf = jax.nn.silu(q.astype(jnp.float32))
    zf = z.astype(jnp.float32)
    lbf = lb.astype(jnp.float32)
    sig = jax.nn.sigmoid(zf)
    f = lbf + (1.0 - lbf) * sig
    log_f = jnp.log(jnp.maximum(f, MIN_FORGET))
    k = (1.0 - lbf) * jax.nn.sigmoid(-zf)
    vf = v.astype(jnp.float32)

    def to_chunks(t, d):
        return t.reshape(bsz, n_chunks, CHUNK, HGRN_HEADS, d).transpose(1, 0, 3, 2, 4)

    qc = to_chunks(qf, HGRN_KEY_DIM)
    kc = to_chunks(k, HGRN_KEY_DIM)
    lfc = to_chunks(log_f, HGRN_KEY_DIM)
    vc = to_chunks(vf, HGRN_VAL_DIM)
    causal = jnp.tril(jnp.ones((CHUNK, CHUNK), dtype=bool))[:, :, None]

    def step(state, inp):
        qi, ki, vi, lfi = inp
        b = jnp.cumsum(lfi, axis=-2)
        inter = jnp.einsum('bhtk,bhkv->bhtv', qi * jnp.exp(b), state)
        diff = b[:, :, :, None, :] - b[:, :, None, :, :]
        decay = jnp.where(causal, jnp.exp(jnp.minimum(diff, 0.0)), 0.0)
        scores = jnp.einsum('bhtk,bhsk,bhtsk->bhts', qi, ki, decay)
        o = inter + jnp.einsum('bhts,bhsv->bhtv', scores, vi)
        b_last = b[:, :, -1:, :]
        new_state = (jnp.exp(b_last[:, :, 0, :])[..., None] * state
                     + jnp.einsum('bhsk,bhsv->bhkv', ki * jnp.exp(b_last - b), vi))
        return new_state, o

    s0 = jnp.zeros((bsz, HGRN_HEADS, HGRN_KEY_DIM, HGRN_VAL_DIM), jnp.float32)
    _, oc = lax.scan(step, s0, (qc, kc, vc, lfc))
    o = oc.transpose(1, 0, 3, 2, 4).reshape(bsz, length, HGRN_HEADS, HGRN_VAL_DIM)
    o = rms_norm(o, gn.reshape(HGRN_HEADS, HGRN_VAL_DIM)).reshape(bsz, length, D_HGRN)
    return (o * jax.nn.silu(g.astype(jnp.float32))).astype(out_dtype)


def setup_inputs(seed: int = 0) -> dict:
    key = jax.random.key(seed)
    ks = jax.random.split(key, 16)
    f32 = jnp.float32

    def nrm(k, shape, scale):
        return jax.random.normal(k, shape, f32) * scale

    return {
        "x": jax.random.normal(ks[0], (BATCH, SEQ, D_MODEL), f32),
        "norm_mix": 1.0 + nrm(ks[1], (DEPTH, D_MODEL), 0.02),
        "w_in": nrm(ks[2], (DEPTH, D_MODEL, D_IN), D_MODEL ** -0.5),
        "conv_w": nrm(ks[3], (DEPTH, CONV_WIDTH, D_CONV), CONV_WIDTH ** -0.5),
        "gn_conv": 1.0 + nrm(ks[4], (DEPTH, D_CONV), 0.02),
        "lb_logits": nrm(ks[5], (DEPTH, D_HGRN), 0.1),
        "gn_hgrn": 1.0 + nrm(ks[6], (DEPTH, D_HGRN), 0.02),
        "w_out": nrm(ks[7], (DEPTH, D_MIX, D_MODEL), D_MIX ** -0.5),
        "norm_ffn": 1.0 + nrm(ks[8], (DEPTH, D_MODEL), 0.02),
        "w_gate": nrm(ks[9], (DEPTH, D_MODEL, D_FF), D_MODEL ** -0.5),
        "w_up": nrm(ks[10], (DEPTH, D_MODEL, D_FF), D_MODEL ** -0.5),
        "w_down": nrm(ks[11], (DEPTH, D_FF, D_MODEL), D_FF ** -0.5),
        "norm_final": 1.0 + nrm(ks[12], (D_MODEL,), 0.02),
    }


def reference(x, norm_mix, w_in, conv_w, gn_conv, lb_logits, gn_hgrn, w_out,
              norm_ffn, w_gate, w_up, w_down, norm_final):
    p = jax.nn.softmax(lb_logits.astype(jnp.float32), axis=0)
    lower_bounds = jnp.clip(jnp.cumsum(p, axis=0) - p[0], 0.0, 1.0 - 1e-4)

    c0, c1, c2 = D_CONV, 2 * D_CONV, 3 * D_CONV
    h0, h1, h2 = c2 + D_HGRN, c2 + 2 * D_HGRN, c2 + 3 * D_HGRN
    for l in range(DEPTH):
        h = rms_norm(x, norm_mix[l])
        proj = h @ w_in[l]
        conv_out = short_conv_mixer(proj[..., :c0], proj[..., c0:c1], proj[..., c1:c2],
                                    conv_w[l], gn_conv[l])
        hgrn_out = hgrn2_mixer(proj[..., c2:h0], proj[..., h0:h1], proj[..., h1:h2],
                               proj[..., h2:], lower_bounds[l], gn_hgrn[l])
        mixed = jnp.concatenate([conv_out, hgrn_out], axis=-1)
        x = x + mixed @ w_out[l]
        h = rms_norm(x, norm_ffn[l])
        x = x + (jax.nn.silu(h @ w_gate[l]) * (h @ w_up[l])) @ w_down[l]
    return rms_norm(x, norm_final)
```

```cpp
#include <hip/hip_runtime.h>
#include <cstdio>
#include <cstdint>
#define MK_ONE_LAUNCH 0
namespace pg8 {
#define PG8_LAS __attribute__((address_space(3)))
typedef unsigned short bf16_t;
typedef short bf16x8 __attribute__((ext_vector_type(8)));
typedef float f32x4 __attribute__((ext_vector_type(4)));
typedef unsigned u32x4 __attribute__((ext_vector_type(4)));
constexpr int BM = 256, BK = 64, HALF = 128, HTB = HALF * BK * 2  , STAGE_BYTES = 8 * HTB, NXCD = 8, WGM = 8;

__host__ __device__ __forceinline__ int lds_byte(int r, int c) { const int st = (r >> 4) * 2 + (c >> 5), rr = r & 15, cc = c & 31, ob = rr * 64 + cc * 2; return st * 1024 + (ob ^ (((ob >> 9) & 1) << 5)); }
__host__ __device__ __forceinline__ void stage_rc(int b, int& R, int& C) { const int st = b / 1024, sb = b % 1024, swz = sb ^ (((sb >> 9) & 1) << 5); R = (st >> 1) * 16 + swz / 64; C = (st & 1) * 32 + (swz % 64) / 2; }
__host__ __device__ __forceinline__ int perm32(int rho) { const int n = rho >> 4, i = rho & 15; return 8 * (i >> 2) + 4 * n + (i & 3); }

struct Unit { int pm, pn; };
struct Gemm { const bf16_t* A; const bf16_t* Bt; int M, N, K; };

struct StaticOrder {
    int nM, nN, nwg, G, c;
    __host__ __device__ void init(int M, int N, int G_, int c_) { nM = M / BM; nN = N / BM; nwg = nM * nN; G = G_; c = c_; }
    __host__ __device__ bool next(int i, Unit& u) const {
        const long L = (long)i * G + c; if (L >= nwg) return false;
        int wgid = (int)L; { const int q = nwg / NXCD, r = nwg % NXCD, xcd = wgid % NXCD, off = wgid / NXCD; wgid = (xcd < r ? xcd * (q + 1) : r * (q + 1) + (xcd - r) * q) + off; }
        const int nig = WGM * nN, gid = wgid / nig, fm = gid * WGM, gsz = (nM - fm) < WGM ? (nM - fm) : WGM;
        u.pm = fm + ((wgid % nig) % gsz); u.pn = (wgid % nig) / gsz; return true;
    }
    __device__ __forceinline__ void a_ready(const Unit&) const {}
    __device__ __forceinline__ void done(const Unit&) const {}
};

__device__ __forceinline__ unsigned cvt_pk_bf16(float lo, float hi) { unsigned r; asm volatile("v_cvt_pk_bf16_f32 %0, %1, %2" : "=v"(r) : "v"(lo), "v"(hi)); return r; }
typedef float f32x2 __attribute__((ext_vector_type(2)));
__device__ __forceinline__ float silu_f(float x) { return x * __builtin_amdgcn_rcpf(1.0f + __builtin_amdgcn_exp2f(-1.44269504089f * x)); }
struct EpiBf16Plain {
    static constexpr bool PERM = true, AFTER_DRAIN = false;
    bf16_t* O; int ldc;
    __device__ __forceinline__ void operator()(const f32x4 (&acc)[2][2][4][2], const Unit& u, int wr, int wc, int fr, int fq) const {
        const int row0 = u.pm * BM + wr * 64 + fr, col0 = u.pn * BM + wc * 32 + 8 * fq;
#pragma unroll
        for (int ai = 0; ai < 2; ++ai)
#pragma unroll
            for (int m = 0; m < 4; ++m) { bf16_t* rowp = O + (size_t)(row0 + ai * HALF + m * 16) * ldc + col0;
#pragma unroll
                for (int bj = 0; bj < 2; ++bj) { const f32x4 v0 = acc[ai][bj][m][0], v1 = acc[ai][bj][m][1];
                    u32x4 w; w.x = cvt_pk_bf16(v0[0], v0[1]); w.y = cvt_pk_bf16(v0[2], v0[3]); w.z = cvt_pk_bf16(v1[0], v1[1]); w.w = cvt_pk_bf16(v1[2], v1[3]);
                    *(u32x4*)(rowp + bj * HALF) = w; } }
    }
};
struct EpiResF32 {
    static constexpr bool PERM = false, AFTER_DRAIN = false;
    const float* res; float* out; int ldc;
    __device__ __forceinline__ void operator()(const f32x4 (&acc)[2][2][4][2], const Unit& u, int wr, int wc, int fr, int fq) const {
        const int row0 = u.pm * BM + wr * 64 + fr, col0 = u.pn * BM + wc * 32 + 4 * fq;
#pragma unroll
        for (int ai = 0; ai < 2; ++ai)
#pragma unroll
            for (int m = 0; m < 4; ++m) { const size_t off = (size_t)(row0 + ai * HALF + m * 16) * ldc + col0;
#pragma unroll
                for (int bj = 0; bj < 2; ++bj)
#pragma unroll
                    for (int n = 0; n < 2; ++n) { const f32x4 r = *(const f32x4*)(res + off + bj * HALF + n * 16); *(f32x4*)(out + off + bj * HALF + n * 16) = r + acc[ai][bj][m][n]; } }
    }
};
struct EpiSwiGLU {
    static constexpr bool PERM = true, AFTER_DRAIN = false;
    bf16_t* H; int ldh;
    __device__ __forceinline__ void operator()(const f32x4 (&acc)[2][2][4][2], const Unit& u, int wr, int wc, int fr, int fq) const {
        const int row0 = u.pm * BM + wr * 64 + fr, col0 = u.pn * HALF + wc * 32 + 8 * fq;
#pragma unroll
        for (int ai = 0; ai < 2; ++ai)
#pragma unroll
            for (int m = 0; m < 4; ++m) { bf16_t* rowp = H + (size_t)(row0 + ai * HALF + m * 16) * ldh + col0;
                const f32x4 g0 = acc[ai][0][m][0], g1 = acc[ai][0][m][1], u0 = acc[ai][1][m][0], u1 = acc[ai][1][m][1];
                u32x4 w; w.x = cvt_pk_bf16(silu_f(g0[0]) * u0[0], silu_f(g0[1]) * u0[1]); w.y = cvt_pk_bf16(silu_f(g0[2]) * u0[2], silu_f(g0[3]) * u0[3]);
                w.z = cvt_pk_bf16(silu_f(g1[0]) * u1[0], silu_f(g1[1]) * u1[1]); w.w = cvt_pk_bf16(silu_f(g1[2]) * u1[2], silu_f(g1[3]) * u1[3]);
                *(u32x4*)rowp = w; }
    }
};

template <class Epi, class Sched, bool ALIGN_EPI = false, bool SP2 = false>
__device__ __forceinline__ void gemm_phase(PG8_LAS unsigned char* lds, const Gemm g, const Sched& S, const Epi& E) {
    int tid_ = threadIdx.x; asm volatile("" : "+v"(tid_));
    const int tid = tid_, wid = __builtin_amdgcn_readfirstlane(tid >> 6), lane = tid & 63, wr = wid >> 2, wc = wid & 3, fr = lane & 15, fq = lane >> 4;
    const int K = g.K, nt = K / BK;
    unsigned voffA[2], voffB[2];
#pragma unroll
    for (int i = 0; i < 2; ++i) { int R, C; stage_rc(tid * 16 + i * 8192, R, C); const int Rb = Epi::PERM ? ((R & ~31) + perm32(R & 31)) : R;
        voffA[i] = (unsigned)(R * K + C) * 2u; voffB[i] = (unsigned)(Rb * K + C) * 2u; }
    const size_t kstep = (size_t)(BK * 2);
    const size_t hstep = (size_t)HALF * K * 2;
    const size_t tstep = 2 * hstep;
    const unsigned ldsw = (unsigned)wid * 1024u;
    const int aoff = lds_byte(wr * 64 + fr, fq * 8), boff = lds_byte(wc * 32 + fr, fq * 8);
#define PG8_SA(b, h) (((b) * 2 + (h)) * HTB)
#define PG8_SB(b, h) ((4 + (b) * 2 + (h)) * HTB)
#define PG8_STAGE(bufoff, gbase, voff) do { _Pragma("unroll") for (int _i = 0; _i < 2; ++_i) \
        __builtin_amdgcn_global_load_lds((const unsigned*)((const char*)(gbase) + (voff)[_i]), (PG8_LAS unsigned*)(lds + (bufoff) + ldsw + _i * 8192), 16, 0, 0); } while (0)
#define PG8_LDA(dst, b, h) do { _Pragma("unroll") for (int m = 0; m < 4; ++m) _Pragma("unroll") for (int k = 0; k < 2; ++k) dst[m][k] = *(const PG8_LAS bf16x8*)(lds + PG8_SA(b, h) + aoff + m * 2048 + k * 1024); } while (0)
#define PG8_LDB(dst, b, h) do { _Pragma("unroll") for (int n = 0; n < 2; ++n) _Pragma("unroll") for (int k = 0; k < 2; ++k) dst[n][k] = *(const PG8_LAS bf16x8*)(lds + PG8_SB(b, h) + boff + n * 2048 + k * 1024); } while (0)
#define PG8_MMA(ai, bj, At, Bt) do { __builtin_amdgcn_s_setprio(1); _Pragma("unroll") for (int m = 0; m < 4; ++m) _Pragma("unroll") for (int n = 0; n < 2; ++n) _Pragma("unroll") for (int k = 0; k < 2; ++k) \
        acc[ai][bj][m][n] = __builtin_amdgcn_mfma_f32_16x16x32_bf16(Bt[n][k], At[m][k], acc[ai][bj][m][n], 0, 0, 0); __builtin_amdgcn_s_setprio(0); } while (0)
#define PG8_WAIT_V(n) asm volatile("s_waitcnt vmcnt(" #n ")" ::: "memory")
#define PG8_WAIT_L(n) asm volatile("s_waitcnt lgkmcnt(" #n ")" ::: "memory")
#define PG8_BAR __builtin_amdgcn_s_barrier()
#define PG8_SCHED __builtin_amdgcn_sched_barrier(0)
    Unit cur, nxt; int ui = 0;
    if (!S.next(0, cur)) return;
    f32x4 acc[2][2][4][2];
#pragma unroll
    for (int a = 0; a < 2; ++a)
#pragma unroll
        for (int b = 0; b < 2; ++b)
#pragma unroll
            for (int m = 0; m < 4; ++m)
#pragma unroll
                for (int n = 0; n < 2; ++n) acc[a][b][m][n] = (f32x4){0.f, 0.f, 0.f, 0.f};
    bf16x8 At[4][2], B0[2][2], B1[2][2];
    const char* cA = (const char*)g.A + (size_t)cur.pm * tstep; const char* cB = (const char*)g.Bt + (size_t)cur.pn * tstep;
    S.a_ready(cur);
    if constexpr (SP2) {
        PG8_STAGE(PG8_SB(0, 0), cB, voffB); PG8_STAGE(PG8_SB(0, 1), cB + hstep, voffB); PG8_STAGE(PG8_SA(0, 0), cA, voffA); PG8_STAGE(PG8_SA(0, 1), cA + hstep, voffA);
        if (wr == 1) PG8_BAR;
        PG8_WAIT_V(2); PG8_BAR;
        PG8_STAGE(PG8_SB(1, 0), cB + kstep, voffB); PG8_STAGE(PG8_SA(1, 0), cA + kstep, voffA); PG8_STAGE(PG8_SB(1, 1), cB + hstep + kstep, voffB);
        PG8_WAIT_V(6); PG8_BAR;
    } else {
        PG8_STAGE(PG8_SB(0, 0), cB, voffB); PG8_STAGE(PG8_SA(0, 0), cA, voffA); PG8_STAGE(PG8_SB(0, 1), cB + hstep, voffB); PG8_STAGE(PG8_SA(0, 1), cA + hstep, voffA);
        if (wr == 1) PG8_BAR;
        PG8_WAIT_V(4); PG8_BAR;
        PG8_STAGE(PG8_SB(1, 0), cB + kstep, voffB); PG8_STAGE(PG8_SA(1, 0), cA + kstep, voffA); PG8_STAGE(PG8_SB(1, 1), cB + hstep + kstep, voffB);
        PG8_WAIT_V(6); PG8_BAR;
    }
    for (;;) {
        const bool has_next = S.next(ui + 1, nxt);
        const char* nA = has_next ? (const char*)g.A + (size_t)nxt.pm * tstep : cA; const char* nB = has_next ? (const char*)g.Bt + (size_t)nxt.pn * tstep : cB;
        for (int t = 0; t < nt; t += 2) {
            const bool last = (t == nt - 2);
            const char* a1 = cA + (size_t)(t + 1) * kstep;
            const char* a2 = last ? nA : cA + (size_t)(t + 2) * kstep; const char* b2 = last ? nB : cB + (size_t)(t + 2) * kstep;
            const char* a3 = a2 + kstep; const char* b3 = b2 + kstep;
            if (last && has_next) S.a_ready(nxt);
            if constexpr (SP2) {
            PG8_LDB(B0, 0, 0); PG8_LDB(B1, 0, 1); PG8_SCHED; PG8_LDA(At, 0, 0); PG8_STAGE(PG8_SA(1, 1), a1 + hstep, voffA);
            PG8_WAIT_V(8); PG8_WAIT_L(0); PG8_BAR; PG8_MMA(0, 0, At, B0); PG8_MMA(0, 1, At, B1); PG8_BAR; PG8_SCHED;
            PG8_LDA(At, 0, 1); PG8_STAGE(PG8_SB(0, 0), b2, voffB); PG8_STAGE(PG8_SB(0, 1), b2 + hstep, voffB); PG8_STAGE(PG8_SA(0, 0), a2, voffA);
            PG8_WAIT_V(8); PG8_WAIT_L(0); PG8_BAR; PG8_MMA(1, 0, At, B0); PG8_MMA(1, 1, At, B1); PG8_BAR; PG8_SCHED;
            PG8_LDB(B0, 1, 0); PG8_LDB(B1, 1, 1); PG8_SCHED; PG8_LDA(At, 1, 0); PG8_STAGE(PG8_SA(0, 1), a2 + hstep, voffA);
            PG8_WAIT_V(8); PG8_WAIT_L(0); PG8_BAR; PG8_MMA(0, 0, At, B0); PG8_MMA(0, 1, At, B1); PG8_BAR; PG8_SCHED;
            PG8_LDA(At, 1, 1); PG8_STAGE(PG8_SB(1, 0), b3, voffB); PG8_STAGE(PG8_SB(1, 1), b3 + hstep, voffB); PG8_STAGE(PG8_SA(1, 0), a3, voffA);
            PG8_WAIT_V(8); PG8_WAIT_L(0); PG8_BAR; PG8_MMA(1, 0, At, B0); PG8_MMA(1, 1, At, B1); PG8_BAR; PG8_SCHED;
            } else {
            PG8_LDB(B0, 0, 0); PG8_SCHED; PG8_LDA(At, 0, 0); PG8_STAGE(PG8_SA(1, 1), a1 + hstep, voffA);
            PG8_WAIT_L(8); PG8_BAR; PG8_WAIT_L(0); PG8_MMA(0, 0, At, B0); PG8_BAR; PG8_SCHED;
            PG8_LDB(B1, 0, 1); PG8_STAGE(PG8_SB(0, 0), b2, voffB);
            PG8_BAR; PG8_WAIT_L(0); PG8_MMA(0, 1, At, B1); PG8_BAR;
            PG8_LDA(At, 0, 1); PG8_STAGE(PG8_SA(0, 0), a2, voffA);
            PG8_BAR; PG8_WAIT_L(0); PG8_MMA(1, 0, At, B0); PG8_BAR; PG8_SCHED;
            PG8_STAGE(PG8_SB(0, 1), b2 + hstep, voffB);
            PG8_WAIT_V(6); PG8_BAR; PG8_MMA(1, 1, At, B1); PG8_BAR;
            PG8_LDB(B0, 1, 0); PG8_SCHED; PG8_LDA(At, 1, 0); PG8_STAGE(PG8_SA(0, 1), a2 + hstep, voffA);
            PG8_WAIT_L(8); PG8_BAR; PG8_WAIT_L(0); PG8_MMA(0, 0, At, B0); PG8_BAR; PG8_SCHED;
            PG8_LDB(B1, 1, 1); PG8_STAGE(PG8_SB(1, 0), b3, voffB);
            PG8_BAR; PG8_WAIT_L(0); PG8_MMA(0, 1, At, B1); PG8_BAR;
            PG8_LDA(At, 1, 1); PG8_STAGE(PG8_SA(1, 0), a3, voffA);
            PG8_BAR; PG8_WAIT_L(0); PG8_MMA(1, 0, At, B0); PG8_BAR; PG8_SCHED;
            PG8_STAGE(PG8_SB(1, 1), b3 + hstep, voffB);
            PG8_WAIT_V(6); PG8_BAR; PG8_MMA(1, 1, At, B1); PG8_BAR;
            }
        }
        if constexpr (ALIGN_EPI) { if (wr == 0) PG8_BAR; }
        if constexpr (!Epi::AFTER_DRAIN) { E(acc, cur, wr, wc, fr, fq); S.done(cur); }
        if (!has_next) break;
#pragma unroll
        for (int a = 0; a < 2; ++a)
#pragma unroll
            for (int b = 0; b < 2; ++b)
#pragma unroll
                for (int m = 0; m < 4; ++m)
#pragma unroll
                    for (int n = 0; n < 2; ++n) acc[a][b][m][n] = (f32x4){0.f, 0.f, 0.f, 0.f};
        cur = nxt; cA = nA; cB = nB; ++ui;
        if constexpr (ALIGN_EPI) { if (wr == 1) PG8_BAR; }
    }
    PG8_WAIT_V(0);
    if constexpr (!ALIGN_EPI) { if (wr == 0) PG8_BAR; }
    PG8_BAR;
    if constexpr (Epi::AFTER_DRAIN) { E.fused(acc, cur, wr, wc, fr, fq, lds, wid, lane); S.done(cur); }
#undef PG8_SA
#undef PG8_SB
#undef PG8_STAGE
#undef PG8_LDA
#undef PG8_LDB
#undef PG8_MMA
#undef PG8_WAIT_V
#undef PG8_WAIT_L
#undef PG8_BAR
#undef PG8_SCHED
}
}

constexpr int NWAVES = 8, NTHR = 512;
constexpr int D = 2048, BATCH = 16, SEQ = 2048, M = BATCH * SEQ, DEPTH = 4;
constexpr int DC = 1024, DH = 1024, DIN = 7168, DFF = 5632, NGU = 2 * DFF, HEADS = 8, HD = 128;
constexpr int C_B = 0, C_C = 1024, C_H = 2048, C_Q = 3072, C_Z = 4096, C_I = 5120, C_G = 6144;
constexpr float EPS = 1e-6f;
#ifndef MK_ONE_LAUNCH
#define MK_ONE_LAUNCH 1
#endif
constexpr int NPH = 2 + 8 * DEPTH;

constexpr size_t MiB = 1u << 20;
constexpr size_t WS_CTL = 0, CTL_ZERO_BYTES = 1 * MiB;
constexpr size_t WS_LB = 1 * MiB;
constexpr size_t WS_WIN = 2 * MiB, SZ_WIN = (size_t)DIN * D * 2;
constexpr size_t WS_WOUT = WS_WIN + DEPTH * SZ_WIN, SZ_WOUT = (size_t)D * D * 2;
constexpr size_t WS_WGU = WS_WOUT + DEPTH * SZ_WOUT, SZ_WGU = (size_t)NGU * D * 2;
constexpr size_t WS_WDN = WS_WGU + DEPTH * SZ_WGU, SZ_WDN = (size_t)D * DFF * 2;
constexpr size_t WS_HB = WS_WDN + DEPTH * SZ_WDN;
constexpr size_t WS_PROJ = WS_HB + (size_t)M * D * 2;
constexpr size_t WS_END = WS_PROJ + (size_t)M * DIN * 2;
constexpr int CW_BAR = 4096;

constexpr int RING_OFF = 0, RING_BYTES = 131072;
constexpr int MISC_OFF = RING_BYTES + 320;
constexpr int LDS_BYTES = 147456;

#define GAS __attribute__((address_space(1)))
#define LAS __attribute__((address_space(3)))
typedef unsigned short bf16;
typedef unsigned v4u __attribute__((ext_vector_type(4)));
typedef unsigned v2u __attribute__((ext_vector_type(2)));
typedef float f32x4 __attribute__((ext_vector_type(4)));
#define LDS_WAIT() asm volatile("s_waitcnt lgkmcnt(0)" ::: "memory")
#define VM_WAIT() asm volatile("s_waitcnt vmcnt(0)" ::: "memory")
__device__ __forceinline__ unsigned pk2(float lo, float hi) { return pg8::cvt_pk_bf16(lo, hi); }
__device__ __forceinline__ float bf_lo(unsigned w) { return __uint_as_float(w << 16); }
__device__ __forceinline__ float bf_hi(unsigned w) { return __uint_as_float(w & 0xffff0000u); }
__device__ __forceinline__ void unpack8(const v4u r, float (&o)[8]) { o[0] = bf_lo(r.x); o[1] = bf_hi(r.x); o[2] = bf_lo(r.y); o[3] = bf_hi(r.y); o[4] = bf_lo(r.z); o[5] = bf_hi(r.z); o[6] = bf_lo(r.w); o[7] = bf_hi(r.w); }
__device__ __forceinline__ v4u pack8(const float (&o)[8]) { v4u w; w.x = pk2(o[0], o[1]); w.y = pk2(o[2], o[3]); w.z = pk2(o[4], o[5]); w.w = pk2(o[6], o[7]); return w; }
__device__ __forceinline__ float wave_sum(float v) {
#pragma unroll
    for (int o = 1; o < 64; o <<= 1) v += __shfl_xor(v, o);
    return v;
}
__device__ __forceinline__ float sum16(float v) {
#pragma unroll
    for (int o = 1; o < 16; o <<= 1) v += __shfl_xor(v, o);
    return v;
}
#define XB_TMO      128
#define XB_XCNT(j)  (256  + 64 * (j))
#define XB_XSUB(j)  (1280 + 64 * (j))
#define XB_XGEN(j)  (2304 + 64 * (j))
#define XB_TOP      3328
#define XB_TOPGEN   3392
#define XCD_BAR_WORDS 3456
#define XB_SPIN_CAP (1u << 18)

__device__ __forceinline__ unsigned xb_ld(unsigned* p)              { return __hip_atomic_load(p, __ATOMIC_RELAXED, __HIP_MEMORY_SCOPE_AGENT); }
__device__ __forceinline__ unsigned xb_add(unsigned* p, unsigned v) { return __hip_atomic_fetch_add(p, v, __ATOMIC_RELAXED, __HIP_MEMORY_SCOPE_AGENT); }
__device__ __forceinline__ unsigned xb_xcc_id() { return (unsigned)__builtin_amdgcn_s_getreg((3 << 11) | 20) & 0xFu; }
#define XB_SPIN(cond, bar) do { unsigned _sp = 0; while (cond) { __builtin_amdgcn_s_sleep(1); \
    if ((++_sp & 255u) == 0u) { if (xb_ld(&(bar)[XB_TMO])) break; if (_sp > XB_SPIN_CAP) { atomicAdd(&(bar)[XB_TMO], 1u); break; } } } } while (0)

struct XcdBarrier {
    unsigned* bar; unsigned x;
    volatile LAS unsigned* st;
};

__device__ __forceinline__ XcdBarrier xcd_barrier_post(unsigned* bar, volatile LAS unsigned* st) {
    XcdBarrier b; b.bar = bar; b.x = xb_xcc_id(); b.st = st;
    if (threadIdx.x == 0) (void)xb_add(&bar[XB_XCNT(b.x)], 1u);
    return b;
}
__device__ __forceinline__ void xcd_barrier_complete(unsigned* bar, unsigned x, unsigned& nloc, unsigned& nx) {
    const unsigned G = gridDim.x * gridDim.y * gridDim.z;
    unsigned sum, cnt, mine, sp = 0u;
    for (;;) {
        sum = 0u; cnt = 0u; mine = 0u;
#pragma unroll
        for (unsigned j = 0; j < 16; ++j) { const unsigned c = xb_ld(&bar[XB_XCNT(j)]); sum += c; cnt += (c > 0u) ? 1u : 0u; mine = (j == x) ? c : mine; }
        if (sum == G) break;
        __builtin_amdgcn_s_sleep(1);
        if ((++sp & 255u) == 0u) { if (xb_ld(&bar[XB_TMO])) break; if (sp > XB_SPIN_CAP) { atomicAdd(&bar[XB_TMO], 1u); break; } }
    }
    nloc = mine > 0u ? mine : 1u; nx = cnt > 0u ? cnt : 1u;
}

__device__ __forceinline__ void xcd_barrier(const XcdBarrier& b) {
    asm volatile("s_waitcnt vmcnt(0)" ::: "memory");
    __syncthreads();
    if (threadIdx.x == 0) {
        unsigned* bar = b.bar;
        __builtin_amdgcn_s_waitcnt(0);
        unsigned nloc = b.st[0], nx = b.st[1];
        if (nloc == 0u) { xcd_barrier_complete(bar, b.x, nloc, nx); b.st[0] = nloc; b.st[1] = nx; }
        const unsigned old = xb_add(&bar[XB_XSUB(b.x)], 1u);
        const unsigned gen = old / nloc;
        if (old + 1u == (gen + 1u) * nloc) {
            __builtin_amdgcn_fence(__ATOMIC_RELEASE, "agent");
            asm volatile("s_waitcnt vmcnt(0)" ::: "memory");
            const unsigned og = xb_add(&bar[XB_TOP], 1u);
            const unsigned tg = og / nx;
            if (og + 1u == (tg + 1u) * nx) xb_add(&bar[XB_TOPGEN], 1u);
            else XB_SPIN(xb_ld(&bar[XB_TOPGEN]) == tg, bar);
            __builtin_amdgcn_fence(__ATOMIC_ACQUIRE, "agent");
            xb_add(&bar[XB_XGEN(b.x)], 1u);
            asm volatile("s_waitcnt vmcnt(0)" ::: "memory");
        } else {
            XB_SPIN(xb_ld(&bar[XB_XGEN(b.x)]) == gen, bar);
            __builtin_amdgcn_fence(__ATOMIC_ACQUIRE, "agent");
            asm volatile("s_waitcnt vmcnt(0)" ::: "memory");
        }
    }
    __syncthreads();
}

__device__ __forceinline__ void transpose_item(const float* W, int K, int N, bf16* WT, int k0, int n0, int drow0, LAS float* scr, int lane) {
#pragma unroll 8
    for (int i = 0; i < 32; ++i) { const int kk = 2 * i + (lane >> 5); scr[kk * 33 + (lane & 31)] = W[(size_t)(k0 + kk) * N + n0 + (lane & 31)]; }
    LDS_WAIT(); asm volatile("" ::: "memory");
    const int c = lane & 7;
#pragma unroll
    for (int j = 0; j < 4; ++j) { const int n = (lane >> 3) + 8 * j; const LAS float* s = scr + (8 * c) * 33 + n;
        v4u o; o.x = pk2(s[0 * 33], s[1 * 33]); o.y = pk2(s[2 * 33], s[3 * 33]); o.z = pk2(s[4 * 33], s[5 * 33]); o.w = pk2(s[6 * 33], s[7 * 33]);
        *(v4u*)(WT + (size_t)(drow0 + n) * K + k0 + 8 * c) = o; }
    LDS_WAIT(); asm volatile("" ::: "memory");
}
__device__ __forceinline__ void prologue_phase(const float* w_in, const float* w_out, const float* w_gate, const float* w_up, const float* w_down, const float* lb_logits,
                                               unsigned char* ws, LAS unsigned char* lds, int gw, int NGW, int wave, int lane, int gtid) {
    LAS float* scr = (LAS float*)(lds + RING_OFF + wave * 16384);
    constexpr int I_IN = (D / 64) * (DIN / 32), I_OUT = (D / 64) * (D / 32), I_G = (D / 64) * (DFF / 32), I_DN = (DFF / 64) * (D / 32);
    constexpr int PER_LAYER = I_IN + I_OUT + 2 * I_G + I_DN, TOTAL = DEPTH * PER_LAYER;
    for (int it = gw; it < TOTAL; it += NGW) {
        const int l = it / PER_LAYER; int r = it % PER_LAYER;
        if (r < I_IN) { const int nb = r % (DIN / 32), kb = r / (DIN / 32);
            transpose_item(w_in + (size_t)l * D * DIN, D, DIN, (bf16*)(ws + WS_WIN + l * SZ_WIN), kb * 64, nb * 32, nb * 32, scr, lane); continue; } r -= I_IN;
        if (r < I_OUT) { const int nb = r % (D / 32), kb = r / (D / 32);
            transpose_item(w_out + (size_t)l * D * D, D, D, (bf16*)(ws + WS_WOUT + l * SZ_WOUT), kb * 64, nb * 32, nb * 32, scr, lane); continue; } r -= I_OUT;
        if (r < I_G) { const int nb = r % (DFF / 32), kb = r / (DFF / 32), n0 = nb * 32;
            transpose_item(w_gate + (size_t)l * D * DFF, D, DFF, (bf16*)(ws + WS_WGU + l * SZ_WGU), kb * 64, n0, (n0 >> 7) * 256 + (n0 & 127), scr, lane); continue; } r -= I_G;
        if (r < I_G) { const int nb = r % (DFF / 32), kb = r / (DFF / 32), n0 = nb * 32;
            transpose_item(w_up + (size_t)l * D * DFF, D, DFF, (bf16*)(ws + WS_WGU + l * SZ_WGU), kb * 64, n0, (n0 >> 7) * 256 + 128 + (n0 & 127), scr, lane); continue; } r -= I_G;
        { const int nb = r % (D / 32), kb = r / (D / 32);
            transpose_item(w_down + (size_t)l * DFF * D, DFF, D, (bf16*)(ws + WS_WDN + l * SZ_WDN), kb * 64, nb * 32, nb * 32, scr, lane); }
    }
    if (gtid < DH) {
        float lg[DEPTH], mx = -3.0e38f;
#pragma unroll
        for (int l = 0; l < DEPTH; ++l) { lg[l] = lb_logits[l * DH + gtid]; mx = fmaxf(mx, lg[l]); }
        float den = 0.f;
#pragma unroll
        for (int l = 0; l < DEPTH; ++l) { lg[l] = __expf(lg[l] - mx); den += lg[l]; }
        float* lbt = (float*)(ws + WS_LB); float cum = 0.f; const float p0 = lg[0] / den;
#pragma unroll
        for (int l = 0; l < DEPTH; ++l) { cum += lg[l] / den; lbt[l * DH + gtid] = fminf(fmaxf(cum - p0, 0.f), 1.0f - 1e-4f); }
    }
}
__device__ __forceinline__ void norm_phase(const float* x, const float* gain, bf16* out, int gw, int NGW, int lane) {
    f32x4 g[8];
#pragma unroll
    for (int j = 0; j < 8; ++j) g[j] = ((const f32x4*)gain)[lane + 64 * j];
    for (int m = gw; m < M; m += NGW) {
        const f32x4* xr = (const f32x4*)(x + (size_t)m * D) + lane;
        f32x4 v[8]; float s = 0.f;
#pragma unroll
        for (int j = 0; j < 8; ++j) { v[j] = xr[64 * j]; s += (v[j].x * v[j].x + v[j].y * v[j].y) + (v[j].z * v[j].z + v[j].w * v[j].w); }
        const float rs = 1.0f / sqrtf(wave_sum(s) * (1.0f / D) + EPS);
        v2u* o = (v2u*)(out + (size_t)m * D) + lane;
#pragma unroll
        for (int j = 0; j < 8; ++j) { const f32x4 y = v[j] * rs * g[j]; v2u w; w.x = pk2(y.x, y.y); w.y = pk2(y.z, y.w); o[64 * j] = w; }
    }
}
__device__ __forceinline__ void final_norm_phase(float* x, const float* gain, int gw, int NGW, int lane) {
    f32x4 g[8];
#pragma unroll
    for (int j = 0; j < 8; ++j) g[j] = ((const f32x4*)gain)[lane + 64 * j];
    for (int m = gw; m < M; m += NGW) {
        f32x4* xr = (f32x4*)(x + (size_t)m * D) + lane;
        f32x4 v[8]; float s = 0.f;
#pragma unroll
        for (int j = 0; j < 8; ++j) { v[j] = xr[64 * j]; s += (v[j].x * v[j].x + v[j].y * v[j].y) + (v[j].z * v[j].z + v[j].w * v[j].w); }
        const float rs = 1.0f / sqrtf(wave_sum(s) * (1.0f / D) + EPS);
#pragma unroll
        for (int j = 0; j < 8; ++j) xr[64 * j] = v[j] * rs * g[j];
    }
}
__device__ __forceinline__ void conv_phase(const bf16* proj, const float* cw, const float* gn, bf16* mixed, int gw, int NGW, int lane) {
    constexpr int R = 16, NSTRIP = M / R;
    float w0[2][8], w1[2][8], w2[2][8], gg[2][8];
#pragma unroll
    for (int i = 0; i < 2; ++i)
#pragma unroll
        for (int e = 0; e < 8; ++e) { const int c = i * 512 + lane * 8 + e; w0[i][e] = cw[c]; w1[i][e] = cw[DC + c]; w2[i][e] = cw[2 * DC + c]; gg[i][e] = gn[c]; }
    for (int strip = gw; strip < NSTRIP; strip += NGW) {
        const int m0 = strip * R, t0 = m0 % SEQ;
        float u1[2][8], u2[2][8];
#pragma unroll
        for (int i = 0; i < 2; ++i) {
            if (t0 == 0) {
#pragma unroll
                for (int e = 0; e < 8; ++e) { u1[i][e] = 0.f; u2[i][e] = 0.f; }
            } else {
                const bf16* p1 = proj + (size_t)(m0 - 1) * DIN + i * 512 + lane * 8; const bf16* p2 = p1 - DIN;
                float c1[8], h1[8], c2[8], h2[8];
                unpack8(*(const v4u*)(p1 + C_C), c1); unpack8(*(const v4u*)(p1 + C_H), h1); unpack8(*(const v4u*)(p2 + C_C), c2); unpack8(*(const v4u*)(p2 + C_H), h2);
#pragma unroll
                for (int e = 0; e < 8; ++e) { u1[i][e] = c1[e] * h1[e]; u2[i][e] = c2[e] * h2[e]; }
            }
        }
        for (int r = 0; r < R; ++r) {
            const size_t m = (size_t)(m0 + r);
#pragma unroll
            for (int i = 0; i < 2; ++i) {
                const bf16* p = proj + m * DIN + i * 512 + lane * 8;
                float bb[8], cc[8], hh[8], y[8]; unpack8(*(const v4u*)(p + C_B), bb); unpack8(*(const v4u*)(p + C_C), cc); unpack8(*(const v4u*)(p + C_H), hh);
                float ss = 0.f;
#pragma unroll
                for (int e = 0; e < 8; ++e) { const float u0 = cc[e] * hh[e]; y[e] = bb[e] * (w0[i][e] * u2[i][e] + w1[i][e] * u1[i][e] + w2[i][e] * u0); ss += y[e] * y[e]; u2[i][e] = u1[i][e]; u1[i][e] = u0; }
                const float rs = 1.0f / sqrtf(sum16(ss) * (1.0f / 128.0f) + EPS);
#pragma unroll
                for (int e = 0; e < 8; ++e) y[e] = y[e] * rs * gg[i][e];
                *(v4u*)(mixed + m * D + i * 512 + lane * 8) = pack8(y);
            }
        }
    }
}
__device__ __forceinline__ void hgrn_rec_phase(const bf16* proj, const float* lbl, bf16* mixed, LAS unsigned char* lds, int tid, int wave, int lane) {
    LAS float* F = (LAS float*)lds; LAS float* KK = F + 4096; LAS float* QS = KK + 4096; LAS float* V = QS + 4096; LAS float* PART = V + 2048;
    const int st = tid >> 4, sk = (tid & 15) * 8, sv = (tid & 15) * 4;
    for (int item = blockIdx.x; item < BATCH * HEADS * 2; item += gridDim.x) {
        const int b = item >> 4, h = (item >> 1) & 7, vh = item & 1;
        float lb[8];
#pragma unroll
        for (int e = 0; e < 8; ++e) lb[e] = lbl[h * HD + sk + e];
        float S[16];
#pragma unroll
        for (int j = 0; j < 16; ++j) S[j] = 0.f;
        const bf16* pq = proj + (size_t)(b * SEQ + st) * DIN + C_Q + h * HD + sk;
        const bf16* pz = proj + (size_t)(b * SEQ + st) * DIN + C_Z + h * HD + sk;
        const bf16* pi = proj + (size_t)(b * SEQ + st) * DIN + C_I + h * HD + vh * 64 + sv;
        v4u rq = *(const v4u*)pq, rz = *(const v4u*)pz; v2u ri = *(const v2u*)pi;
        for (int c = 0; c < SEQ / 32; ++c) {
            { float q[8], z[8], f[8], kk[8], qs[8]; unpack8(rq, q); unpack8(rz, z);
#pragma unroll
              for (int e = 0; e < 8; ++e) { const float t = __expf(-fabsf(z[e])), r = 1.0f / (1.0f + t), sp = r, sn = t * r;
                  const float sig = z[e] >= 0.f ? sp : sn, nsig = z[e] >= 0.f ? sn : sp; const float oml = 1.0f - lb[e];
                  f[e] = lb[e] + oml * sig; kk[e] = oml * nsig; qs[e] = pg8::silu_f(q[e]); }
              LAS f32x4* pf = (LAS f32x4*)(F + st * 128 + sk); pf[0] = (f32x4){f[0], f[1], f[2], f[3]}; pf[1] = (f32x4){f[4], f[5], f[6], f[7]};
              LAS f32x4* pk = (LAS f32x4*)(KK + st * 128 + sk); pk[0] = (f32x4){kk[0], kk[1], kk[2], kk[3]}; pk[1] = (f32x4){kk[4], kk[5], kk[6], kk[7]};
              LAS f32x4* ps = (LAS f32x4*)(QS + st * 128 + sk); ps[0] = (f32x4){qs[0], qs[1], qs[2], qs[3]}; ps[1] = (f32x4){qs[4], qs[5], qs[6], qs[7]};
              *(LAS f32x4*)(V + st * 64 + sv) = (f32x4){bf_lo(ri.x), bf_hi(ri.x), bf_lo(ri.y), bf_hi(ri.y)}; }
            __syncthreads();
            if (c + 1 < SEQ / 32) { const size_t o = (size_t)(c + 1) * 32 * DIN; rq = *(const v4u*)(pq + o); rz = *(const v4u*)(pz + o); ri = *(const v2u*)(pi + o); }
#pragma unroll 2
            for (int t = 0; t < 32; ++t) {
                const LAS f32x4* pf = (const LAS f32x4*)(F + t * 128 + wave * 16); const LAS f32x4* pk = (const LAS f32x4*)(KK + t * 128 + wave * 16); const LAS f32x4* ps = (const LAS f32x4*)(QS + t * 128 + wave * 16);
                const float vt = V[t * 64 + lane]; float p = 0.f;
#pragma unroll
                for (int i = 0; i < 4; ++i) { const f32x4 f = pf[i], k = pk[i], q = ps[i];
#pragma unroll
                    for (int e = 0; e < 4; ++e) { S[4 * i + e] = f[e] * S[4 * i + e] + k[e] * vt; p += q[e] * S[4 * i + e]; } }
                PART[(t * 8 + wave) * 64 + lane] = p;
            }
            __syncthreads();
            { f32x4 acc = (f32x4){0.f, 0.f, 0.f, 0.f};
#pragma unroll
              for (int w = 0; w < 8; ++w) acc += *(const LAS f32x4*)(PART + (st * 8 + w) * 64 + sv);
              v2u o; o.x = pk2(acc.x, acc.y); o.y = pk2(acc.z, acc.w);
              *(v2u*)(mixed + (size_t)(b * SEQ + c * 32 + st) * D + DC + h * HD + vh * 64 + sv) = o; }
        }
        __syncthreads();
    }
}
__device__ __forceinline__ void hgrn_fin_phase(const bf16* proj, const float* gn, bf16* mixed, int gw, int NGW, int lane) {
    float gg[2][8];
#pragma unroll
    for (int i = 0; i < 2; ++i)
#pragma unroll
        for (int e = 0; e < 8; ++e) gg[i][e] = gn[i * 512 + lane * 8 + e];
    for (int m = gw; m < M; m += NGW) {
#pragma unroll
        for (int i = 0; i < 2; ++i) {
            bf16* po = mixed + (size_t)m * D + DC + i * 512 + lane * 8;
            float o[8], g[8]; unpack8(*(const v4u*)po, o); unpack8(*(const v4u*)(proj + (size_t)m * DIN + C_G + i * 512 + lane * 8), g);
            float ss = 0.f;
#pragma unroll
            for (int e = 0; e < 8; ++e) ss += o[e] * o[e];
            const float rs = 1.0f / sqrtf(sum16(ss) * (1.0f / 128.0f) + EPS);
#pragma unroll
            for (int e = 0; e < 8; ++e) o[e] = o[e] * rs * gg[i][e] * pg8::silu_f(g[e]);
            *(v4u*)po = pack8(o);
        }
    }
}

struct Args { const float* in[13]; float* out; unsigned char* ws; int ph_lo, ph_hi; };
__global__ void __launch_bounds__(NTHR, 2) fwd(Args args) {
    extern __shared__ __attribute__((aligned(16))) unsigned char lds_raw[];
    LAS unsigned char* lds = (LAS unsigned char*)lds_raw;
    volatile LAS unsigned* MISC = (volatile LAS unsigned*)(lds + MISC_OFF);
    const int tid = threadIdx.x, lane = tid & 63, wave = __builtin_amdgcn_readfirstlane(tid >> 6);
    const int G = gridDim.x, bx = blockIdx.x, vcu = (G % 8 == 0) ? (bx % 8) * (G / 8) + bx / 8 : bx;
    const int gw = vcu * NWAVES + wave, NGW = G * NWAVES, gtid = vcu * NTHR + tid;
    unsigned char* ws = args.ws;
    unsigned* ctl = (unsigned*)(ws + WS_CTL);
    if (tid < 32) MISC[tid] = 0u;
    __syncthreads();
#if MK_ONE_LAUNCH
    XcdBarrier bar = xcd_barrier_post(ctl + CW_BAR, MISC + 8);
#define GRID_BAR() xcd_barrier(bar)
#else
#define GRID_BAR() do { } while (0)
#endif
    const float* x_in = args.in[0]; const float* norm_mix = args.in[1]; const float* w_in = args.in[2]; const float* conv_w = args.in[3]; const float* gn_conv = args.in[4];
    const float* lb_logits = args.in[5]; const float* gn_hgrn = args.in[6]; const float* w_out = args.in[7]; const float* norm_ffn = args.in[8];
    const float* w_gate = args.in[9]; const float* w_up = args.in[10]; const float* w_down = args.in[11]; const float* norm_final = args.in[12];
    float* out = args.out;
    bf16* HB = (bf16*)(ws + WS_HB); bf16* PROJ = (bf16*)(ws + WS_PROJ);
    const float* LBT = (const float*)(ws + WS_LB);
    const int lo = args.ph_lo, hi = args.ph_hi;
#define IN(k) (lo <= (k) && (k) < hi)
#define SEAM(k) do { if (IN((k) + 1)) GRID_BAR(); } while (0)

    if (IN(0)) { prologue_phase(w_in, w_out, w_gate, w_up, w_down, lb_logits, ws, lds, gw, NGW, wave, lane, gtid); SEAM(0); }
    for (int l = 0; l < DEPTH; ++l) {
        const int p = 1 + 8 * l;
        int tq = threadIdx.x; asm volatile("" : "+v"(tq));
        const int tid = tq, lane = tq & 63;
        const float* xs = (l == 0) ? x_in : out;
        if (IN(p + 0)) { norm_phase(xs, norm_mix + l * D, HB, gw, NGW, lane); SEAM(p + 0); }
        if (IN(p + 1)) {
            pg8::Gemm g{HB, (const bf16*)(ws + WS_WIN + l * SZ_WIN), M, DIN, D}; pg8::StaticOrder S; S.init(M, DIN, G, bx);
            pg8::EpiBf16Plain E{PROJ, DIN};
            pg8::gemm_phase<pg8::EpiBf16Plain, pg8::StaticOrder, true, true>(lds + RING_OFF, g, S, E);
            SEAM(p + 1); }
        if (IN(p + 2)) {
            hgrn_rec_phase(PROJ, LBT + l * DH, HB, lds + RING_OFF, tid, wave, lane);
            conv_phase(PROJ, conv_w + l * 3 * DC, gn_conv + l * DC, HB, gw, NGW, lane);
            SEAM(p + 2); }
        if (IN(p + 3)) { hgrn_fin_phase(PROJ, gn_hgrn + l * DH, HB, gw, NGW, lane); SEAM(p + 3); }
        if (IN(p + 4)) {
            pg8::Gemm g{HB, (const bf16*)(ws + WS_WOUT + l * SZ_WOUT), M, D, D}; pg8::StaticOrder S; S.init(M, D, G, bx);
            pg8::EpiResF32 E{xs, out, D};
            pg8::gemm_phase<pg8::EpiResF32, pg8::StaticOrder, true, true>(lds + RING_OFF, g, S, E);
            SEAM(p + 4); }
        if (IN(p + 5)) { norm_phase(out, norm_ffn + l * D, HB, gw, NGW, lane); SEAM(p + 5); }
        if (IN(p + 6)) {
            pg8::Gemm g{HB, (const bf16*)(ws + WS_WGU + l * SZ_WGU), M, NGU, D}; pg8::StaticOrder S; S.init(M, NGU, G, bx);
            pg8::EpiSwiGLU E{PROJ, DFF};
            pg8::gemm_phase<pg8::EpiSwiGLU, pg8::StaticOrder, true, true>(lds + RING_OFF, g, S, E);
            SEAM(p + 6); }
        if (IN(p + 7)) {
            pg8::Gemm g{PROJ, (const bf16*)(ws + WS_WDN + l * SZ_WDN), M, D, DFF}; pg8::StaticOrder S; S.init(M, D, G, bx);
            pg8::EpiResF32 E{out, out, D};
            pg8::gemm_phase<pg8::EpiResF32, pg8::StaticOrder, true, true>(lds + RING_OFF, g, S, E);
            SEAM(p + 7); }
    }
    if (IN(NPH - 1)) final_norm_phase(out, norm_final, gw, NGW, lane);
#undef IN
#undef SEAM
}

extern "C" void kernel_launch(void* const* d_in, const int* in_sizes, int n_in, void* d_out, int out_size, void* d_ws, size_t ws_size, hipStream_t stream) {
    static int grid = 0;
    if (grid == 0) {
        if (n_in != 13 || in_sizes[0] != M * D || out_size != M * D || ws_size < WS_END) { fprintf(stderr, "kernel_launch: unexpected shapes (n_in %d, in0 %d, out %d, ws %zu < %zu); nothing launched\n", n_in, n_in > 0 ? in_sizes[0] : -1, out_size, ws_size, (size_t)WS_END); grid = -1; return; }
        int dev = 0, cus = 0;
        if (hipGetDevice(&dev) != hipSuccess || hipDeviceGetAttribute(&cus, hipDeviceAttributeMultiprocessorCount, dev) != hipSuccess) { grid = -1; return; }
        if (hipFuncSetAttribute((const void*)fwd, hipFuncAttributeMaxDynamicSharedMemorySize, LDS_BYTES) != hipSuccess) { fprintf(stderr, "kernel_launch: hipFuncSetAttribute failed\n"); grid = -1; return; }
        (void)hipGetLastError();
        grid = cus;
    }
    if (grid < 0) return;
    (void)hipMemsetAsync((char*)d_ws + WS_CTL, 0, CTL_ZERO_BYTES, stream);
    Args a{};
    for (int i = 0; i < 13; ++i) a.in[i] = (const float*)d_in[i];
    a.out = (float*)d_out; a.ws = (unsigned char*)d_ws;
#if MK_ONE_LAUNCH
    a.ph_lo = 0; a.ph_hi = NPH;
    hipLaunchKernelGGL(fwd, dim3(grid), dim3(NTHR), LDS_BYTES, stream, a);
#else
    for (int p = 0; p < NPH; ++p) { a.ph_lo = p; a.ph_hi = p + 1; hipLaunchKernelGGL(fwd, dim3(grid), dim3(NTHR), LDS_BYTES, stream, a); }
#endif
}
```

```cpp
#include <hip/hip_runtime.h>
#include <cstdio>
#include <cstdint>
#define MK_ONE_LAUNCH 1
namespace pg8 {
#define PG8_LAS __attribute__((address_space(3)))
typedef unsigned short bf16_t;
typedef short bf16x8 __attribute__((ext_vector_type(8)));
typedef float f32x4 __attribute__((ext_vector_type(4)));
typedef unsigned u32x4 __attribute__((ext_vector_type(4)));
constexpr int BM = 256, BK = 64, HALF = 128, HTB = HALF * BK * 2  , STAGE_BYTES = 8 * HTB, NXCD = 8, WGM = 8;

__host__ __device__ __forceinline__ int lds_byte(int r, int c) { const int st = (r >> 4) * 2 + (c >> 5), rr = r & 15, cc = c & 31, ob = rr * 64 + cc * 2; return st * 1024 + (ob ^ (((ob >> 9) & 1) << 5)); }
__host__ __device__ __forceinline__ void stage_rc(int b, int& R, int& C) { const int st = b / 1024, sb = b % 1024, swz = sb ^ (((sb >> 9) & 1) << 5); R = (st >> 1) * 16 + swz / 64; C = (st & 1) * 32 + (swz % 64) / 2; }
__host__ __device__ __forceinline__ int perm32(int rho) { const int n = rho >> 4, i = rho & 15; return 8 * (i >> 2) + 4 * n + (i & 3); }

struct Unit { int pm, pn; };
struct Gemm { const bf16_t* A; const bf16_t* Bt; int M, N, K; };

struct StaticOrder {
    int nM, nN, nwg, G, c;
    __host__ __device__ void init(int M, int N, int G_, int c_) { nM = M / BM; nN = N / BM; nwg = nM * nN; G = G_; c = c_; }
    __host__ __device__ bool next(int i, Unit& u) const {
        const long L = (long)i * G + c; if (L >= nwg) return false;
        int wgid = (int)L; { const int q = nwg / NXCD, r = nwg % NXCD, xcd = wgid % NXCD, off = wgid / NXCD; wgid = (xcd < r ? xcd * (q + 1) : r * (q + 1) + (xcd - r) * q) + off; }
        const int nig = WGM * nN, gid = wgid / nig, fm = gid * WGM, gsz = (nM - fm) < WGM ? (nM - fm) : WGM;
        u.pm = fm + ((wgid % nig) % gsz); u.pn = (wgid % nig) / gsz; return true;
    }
    __device__ __forceinline__ void a_ready(const Unit&) const {}
    __device__ __forceinline__ void done(const Unit&) const {}
};

__device__ __forceinline__ unsigned cvt_pk_bf16(float lo, float hi) { unsigned r; asm volatile("v_cvt_pk_bf16_f32 %0, %1, %2" : "=v"(r) : "v"(lo), "v"(hi)); return r; }
typedef float f32x2 __attribute__((ext_vector_type(2)));
__device__ __forceinline__ float silu_f(float x) { return x * __builtin_amdgcn_rcpf(1.0f + __builtin_amdgcn_exp2f(-1.44269504089f * x)); }
struct EpiBf16Plain {
    static constexpr bool PERM = true, AFTER_DRAIN = false;
    bf16_t* O; int ldc;
    __device__ __forceinline__ void operator()(const f32x4 (&acc)[2][2][4][2], const Unit& u, int wr, int wc, int fr, int fq) const {
        const int row0 = u.pm * BM + wr * 64 + fr, col0 = u.pn * BM + wc * 32 + 8 * fq;
#pragma unroll
        for (int ai = 0; ai < 2; ++ai)
#pragma unroll
            for (int m = 0; m < 4; ++m) { bf16_t* rowp = O + (size_t)(row0 + ai * HALF + m * 16) * ldc + col0;
#pragma unroll
                for (int bj = 0; bj < 2; ++bj) { const f32x4 v0 = acc[ai][bj][m][0], v1 = acc[ai][bj][m][1];
                    u32x4 w; w.x = cvt_pk_bf16(v0[0], v0[1]); w.y = cvt_pk_bf16(v0[2], v0[3]); w.z = cvt_pk_bf16(v1[0], v1[1]); w.w = cvt_pk_bf16(v1[2], v1[3]);
                    *(u32x4*)(rowp + bj * HALF) = w; } }
    }
};
struct EpiResF32 {
    static constexpr bool PERM = false, AFTER_DRAIN = false;
    const float* res; float* out; int ldc;
    __device__ __forceinline__ void operator()(const f32x4 (&acc)[2][2][4][2], const Unit& u, int wr, int wc, int fr, int fq) const {
        const int row0 = u.pm * BM + wr * 64 + fr, col0 = u.pn * BM + wc * 32 + 4 * fq;
#pragma unroll
        for (int ai = 0; ai < 2; ++ai)
#pragma unroll
            for (int m = 0; m < 4; ++m) { const size_t off = (size_t)(row0 + ai * HALF + m * 16) * ldc + col0;
#pragma unroll
                for (int bj = 0; bj < 2; ++bj)
#pragma unroll
                    for (int n = 0; n < 2; ++n) { const f32x4 r = *(const f32x4*)(res + off + bj * HALF + n * 16); *(f32x4*)(out + off + bj * HALF + n * 16) = r + acc[ai][bj][m][n]; } }
    }
};
struct EpiSwiGLU {
    static constexpr bool PERM = true, AFTER_DRAIN = false;
    bf16_t* H; int ldh;
    __device__ __forceinline__ void operator()(const f32x4 (&acc)[2][2][4][2], const Unit& u, int wr, int wc, int fr, int fq) const {
        const int row0 = u.pm * BM + wr * 64 + fr, col0 = u.pn * HALF + wc * 32 + 8 * fq;
#pragma unroll
        for (int ai = 0; ai < 2; ++ai)
#pragma unroll
            for (int m = 0; m < 4; ++m) { bf16_t* rowp = H + (size_t)(row0 + ai * HALF + m * 16) * ldh + col0;
                const f32x4 g0 = acc[ai][0][m][0], g1 = acc[ai][0][m][1], u0 = acc[ai][1][m][0], u1 = acc[ai][1][m][1];
                u32x4 w; w.x = cvt_pk_bf16(silu_f(g0[0]) * u0[0], silu_f(g0[1]) * u0[1]); w.y = cvt_pk_bf16(silu_f(g0[2]) * u0[2], silu_f(g0[3]) * u0[3]);
                w.z = cvt_pk_bf16(silu_f(g1[0]) * u1[0], silu_f(g1[1]) * u1[1]); w.w = cvt_pk_bf16(silu_f(g1[2]) * u1[2], silu_f(g1[3]) * u1[3]);
                *(u32x4*)rowp = w; }
    }
};

template <class Epi, class Sched, bool ALIGN_EPI = false, bool SP2 = false>
__device__ __forceinline__ void gemm_phase(PG8_LAS unsigned char* lds, const Gemm g, const Sched& S, const Epi& E) {
    int tid_ = threadIdx.x; asm volatile("" : "+v"(tid_));
    const int tid = tid_, wid = __builtin_amdgcn_readfirstlane(tid >> 6), lane = tid & 63, wr = wid >> 2, wc = wid & 3, fr = lane & 15, fq = lane >> 4;
    const int K = g.K, nt = K / BK;
    unsigned voffA[2], voffB[2];
#pragma unroll
    for (int i = 0; i < 2; ++i) { int R, C; stage_rc(tid * 16 + i * 8192, R, C); const int Rb = Epi::PERM ? ((R & ~31) + perm32(R & 31)) : R;
        voffA[i] = (unsigned)(R * K + C) * 2u; voffB[i] = (unsigned)(Rb * K + C) * 2u; }
    const size_t kstep = (size_t)(BK * 2);
    const size_t hstep = (size_t)HALF * K * 2;
    const size_t tstep = 2 * hstep;
    const unsigned ldsw = (unsigned)wid * 1024u;
    const int aoff = lds_byte(wr * 64 + fr, fq * 8), boff = lds_byte(wc * 32 + fr, fq * 8);
#define PG8_SA(b, h) (((b) * 2 + (h)) * HTB)
#define PG8_SB(b, h) ((4 + (b) * 2 + (h)) * HTB)
#define PG8_STAGE(bufoff, gbase, voff) do { _Pragma("unroll") for (int _i = 0; _i < 2; ++_i) \
        __builtin_amdgcn_global_load_lds((const unsigned*)((const char*)(gbase) + (voff)[_i]), (PG8_LAS unsigned*)(lds + (bufoff) + ldsw + _i * 8192), 16, 0, 0); } while (0)
#define PG8_LDA(dst, b, h) do { _Pragma("unroll") for (int m = 0; m < 4; ++m) _Pragma("unroll") for (int k = 0; k < 2; ++k) dst[m][k] = *(const PG8_LAS bf16x8*)(lds + PG8_SA(b, h) + aoff + m * 2048 + k * 1024); } while (0)
#define PG8_LDB(dst, b, h) do { _Pragma("unroll") for (int n = 0; n < 2; ++n) _Pragma("unroll") for (int k = 0; k < 2; ++k) dst[n][k] = *(const PG8_LAS bf16x8*)(lds + PG8_SB(b, h) + boff + n * 2048 + k * 1024); } while (0)
#define PG8_MMA(ai, bj, At, Bt) do { __builtin_amdgcn_s_setprio(1); _Pragma("unroll") for (int m = 0; m < 4; ++m) _Pragma("unroll") for (int n = 0; n < 2; ++n) _Pragma("unroll") for (int k = 0; k < 2; ++k) \
        acc[ai][bj][m][n] = __builtin_amdgcn_mfma_f32_16x16x32_bf16(Bt[n][k], At[m][k], acc[ai][bj][m][n], 0, 0, 0); __builtin_amdgcn_s_setprio(0); } while (0)
#define PG8_WAIT_V(n) asm volatile("s_waitcnt vmcnt(" #n ")" ::: "memory")
#define PG8_WAIT_L(n) asm volatile("s_waitcnt lgkmcnt(" #n ")" ::: "memory")
#define PG8_BAR __builtin_amdgcn_s_barrier()
#define PG8_SCHED __builtin_amdgcn_sched_barrier(0)
    Unit cur, nxt; int ui = 0;
    if (!S.next(0, cur)) return;
    f32x4 acc[2][2][4][2];
#pragma unroll
    for (int a = 0; a < 2; ++a)
#pragma unroll
        for (int b = 0; b < 2; ++b)
#pragma unroll
            for (int m = 0; m < 4; ++m)
#pragma unroll
                for (int n = 0; n < 2; ++n) acc[a][b][m][n] = (f32x4){0.f, 0.f, 0.f, 0.f};
    bf16x8 At[4][2], B0[2][2], B1[2][2];
    const char* cA = (const char*)g.A + (size_t)cur.pm * tstep; const char* cB = (const char*)g.Bt + (size_t)cur.pn * tstep;
    S.a_ready(cur);
    if constexpr (SP2) {
        PG8_STAGE(PG8_SB(0, 0), cB, voffB); PG8_STAGE(PG8_SB(0, 1), cB + hstep, voffB); PG8_STAGE(PG8_SA(0, 0), cA, voffA); PG8_STAGE(PG8_SA(0, 1), cA + hstep, voffA);
        if (wr == 1) PG8_BAR;
        PG8_WAIT_V(2); PG8_BAR;
        PG8_STAGE(PG8_SB(1, 0), cB + kstep, voffB); PG8_STAGE(PG8_SA(1, 0), cA + kstep, voffA); PG8_STAGE(PG8_SB(1, 1), cB + hstep + kstep, voffB);
        PG8_WAIT_V(6); PG8_BAR;
    } else {
        PG8_STAGE(PG8_SB(0, 0), cB, voffB); PG8_STAGE(PG8_SA(0, 0), cA, voffA); PG8_STAGE(PG8_SB(0, 1), cB + hstep, voffB); PG8_STAGE(PG8_SA(0, 1), cA + hstep, voffA);
        if (wr == 1) PG8_BAR;
        PG8_WAIT_V(4); PG8_BAR;
        PG8_STAGE(PG8_SB(1, 0), cB + kstep, voffB); PG8_STAGE(PG8_SA(1, 0), cA + kstep, voffA); PG8_STAGE(PG8_SB(1, 1), cB + hstep + kstep, voffB);
        PG8_WAIT_V(6); PG8_BAR;
    }
    for (;;) {
        const bool has_next = S.next(ui + 1, nxt);
        const char* nA = has_next ? (const char*)g.A + (size_t)nxt.pm * tstep : cA; const char* nB = has_next ? (const char*)g.Bt + (size_t)nxt.pn * tstep : cB;
        for (int t = 0; t < nt; t += 2) {
            const bool last = (t == nt - 2);
            const char* a1 = cA + (size_t)(t + 1) * kstep;
            const char* a2 = last ? nA : cA + (size_t)(t + 2) * kstep; const char* b2 = last ? nB : cB + (size_t)(t + 2) * kstep;
            const char* a3 = a2 + kstep; const char* b3 = b2 + kstep;
            if (last && has_next) S.a_ready(nxt);
            if constexpr (SP2) {
            PG8_LDB(B0, 0, 0); PG8_LDB(B1, 0, 1); PG8_SCHED; PG8_LDA(At, 0, 0); PG8_STAGE(PG8_SA(1, 1), a1 + hstep, voffA);
            PG8_WAIT_V(8); PG8_WAIT_L(0); PG8_BAR; PG8_MMA(0, 0, At, B0); PG8_MMA(0, 1, At, B1); PG8_BAR; PG8_SCHED;
            PG8_LDA(At, 0, 1); PG8_STAGE(PG8_SB(0, 0), b2, voffB); PG8_STAGE(PG8_SB(0, 1), b2 + hstep, voffB); PG8_STAGE(PG8_SA(0, 0), a2, voffA);
            PG8_WAIT_V(8); PG8_WAIT_L(0); PG8_BAR; PG8_MMA(1, 0, At, B0); PG8_MMA(1, 1, At, B1); PG8_BAR; PG8_SCHED;
            PG8_LDB(B0, 1, 0); PG8_LDB(B1, 1, 1); PG8_SCHED; PG8_LDA(At, 1, 0); PG8_STAGE(PG8_SA(0, 1), a2 + hstep, voffA);
            PG8_WAIT_V(8); PG8_WAIT_L(0); PG8_BAR; PG8_MMA(0, 0, At, B0); PG8_MMA(0, 1, At, B1); PG8_BAR; PG8_SCHED;
            PG8_LDA(At, 1, 1); PG8_STAGE(PG8_SB(1, 0), b3, voffB); PG8_STAGE(PG8_SB(1, 1), b3 + hstep, voffB); PG8_STAGE(PG8_SA(1, 0), a3, voffA);
            PG8_WAIT_V(8); PG8_WAIT_L(0); PG8_BAR; PG8_MMA(1, 0, At, B0); PG8_MMA(1, 1, At, B1); PG8_BAR; PG8_SCHED;
            } else {
            PG8_LDB(B0, 0, 0); PG8_SCHED; PG8_LDA(At, 0, 0); PG8_STAGE(PG8_SA(1, 1), a1 + hstep, voffA);
            PG8_WAIT_L(8); PG8_BAR; PG8_WAIT_L(0); PG8_MMA(0, 0, At, B0); PG8_BAR; PG8_SCHED;
            PG8_LDB(B1, 0, 1); PG8_STAGE(PG8_SB(0, 0), b2, voffB);
            PG8_BAR; PG8_WAIT_L(0); PG8_MMA(0, 1, At, B1); PG8_BAR;
            PG8_LDA(At, 0, 1); PG8_STAGE(PG8_SA(0, 0), a2, voffA);
            PG8_BAR; PG8_WAIT_L(0); PG8_MMA(1, 0, At, B0); PG8_BAR; PG8_SCHED;
            PG8_STAGE(PG8_SB(0, 1), b2 + hstep, voffB);
            PG8_WAIT_V(6); PG8_BAR; PG8_MMA(1, 1, At, B1); PG8_BAR;
            PG8_LDB(B0, 1, 0); PG8_SCHED; PG8_LDA(At, 1, 0); PG8_STAGE(PG8_SA(0, 1), a2 + hstep, voffA);
            PG8_WAIT_L(8); PG8_BAR; PG8_WAIT_L(0); PG8_MMA(0, 0, At, B0); PG8_BAR; PG8_SCHED;
            PG8_LDB(B1, 1, 1); PG8_STAGE(PG8_SB(1, 0), b3, voffB);
            PG8_BAR; PG8_WAIT_L(0); PG8_MMA(0, 1, At, B1); PG8_BAR;
            PG8_LDA(At, 1, 1); PG8_STAGE(PG8_SA(1, 0), a3, voffA);
            PG8_BAR; PG8_WAIT_L(0); PG8_MMA(1, 0, At, B0); PG8_BAR; PG8_SCHED;
            PG8_STAGE(PG8_SB(1, 1), b3 + hstep, voffB);
            PG8_WAIT_V(6); PG8_BAR; PG8_MMA(1, 1, At, B1); PG8_BAR;
            }
        }
        if constexpr (ALIGN_EPI) { if (wr == 0) PG8_BAR; }
        if constexpr (!Epi::AFTER_DRAIN) { E(acc, cur, wr, wc, fr, fq); S.done(cur); }
        if (!has_next) break;
#pragma unroll
        for (int a = 0; a < 2; ++a)
#pragma unroll
            for (int b = 0; b < 2; ++b)
#pragma unroll
                for (int m = 0; m < 4; ++m)
#pragma unroll
                    for (int n = 0; n < 2; ++n) acc[a][b][m][n] = (f32x4){0.f, 0.f, 0.f, 0.f};
        cur = nxt; cA = nA; cB = nB; ++ui;
        if constexpr (ALIGN_EPI) { if (wr == 1) PG8_BAR; }
    }
    PG8_WAIT_V(0);
    if constexpr (!ALIGN_EPI) { if (wr == 0) PG8_BAR; }
    PG8_BAR;
    if constexpr (Epi::AFTER_DRAIN) { E.fused(acc, cur, wr, wc, fr, fq, lds, wid, lane); S.done(cur); }
#undef PG8_SA
#undef PG8_SB
#undef PG8_STAGE
#undef PG8_LDA
#undef PG8_LDB
#undef PG8_MMA
#undef PG8_WAIT_V
#undef PG8_WAIT_L
#undef PG8_BAR
#undef PG8_SCHED
}
}

constexpr int NWAVES = 8, NTHR = 512;
constexpr int D = 2048, BATCH = 16, SEQ = 2048, M = BATCH * SEQ, DEPTH = 4;
constexpr int DC = 1024, DH = 1024, DIN = 7168, DFF = 5632, NGU = 2 * DFF, HEADS = 8, HD = 128;
constexpr int C_B = 0, C_C = 1024, C_H = 2048, C_Q = 3072, C_Z = 4096, C_I = 5120, C_G = 6144;
constexpr float EPS = 1e-6f;
#ifndef MK_ONE_LAUNCH
#define MK_ONE_LAUNCH 1
#endif
constexpr int NPH = 2 + 8 * DEPTH;

constexpr size_t MiB = 1u << 20;
constexpr size_t WS_CTL = 0, CTL_ZERO_BYTES = 1 * MiB;
constexpr size_t WS_LB = 1 * MiB;
constexpr size_t WS_WIN = 2 * MiB, SZ_WIN = (size_t)DIN * D * 2;
constexpr size_t WS_WOUT = WS_WIN + DEPTH * SZ_WIN, SZ_WOUT = (size_t)D * D * 2;
constexpr size_t WS_WGU = WS_WOUT + DEPTH * SZ_WOUT, SZ_WGU = (size_t)NGU * D * 2;
constexpr size_t WS_WDN = WS_WGU + DEPTH * SZ_WGU, SZ_WDN = (size_t)D * DFF * 2;
constexpr size_t WS_HB = WS_WDN + DEPTH * SZ_WDN;
constexpr size_t WS_PROJ = WS_HB + (size_t)M * D * 2;
constexpr size_t WS_END = WS_PROJ + (size_t)M * DIN * 2;
constexpr int CW_BAR = 4096;

constexpr int RING_OFF = 0, RING_BYTES = 131072;
constexpr int MISC_OFF = RING_BYTES + 320;
constexpr int LDS_BYTES = 147456;

#define GAS __attribute__((address_space(1)))
#define LAS __attribute__((address_space(3)))
typedef unsigned short bf16;
typedef unsigned v4u __attribute__((ext_vector_type(4)));
typedef unsigned v2u __attribute__((ext_vector_type(2)));
typedef float f32x4 __attribute__((ext_vector_type(4)));
#define LDS_WAIT() asm volatile("s_waitcnt lgkmcnt(0)" ::: "memory")
#define VM_WAIT() asm volatile("s_waitcnt vmcnt(0)" ::: "memory")
__device__ __forceinline__ unsigned pk2(float lo, float hi) { return pg8::cvt_pk_bf16(lo, hi); }
__device__ __forceinline__ float bf_lo(unsigned w) { return __uint_as_float(w << 16); }
__device__ __forceinline__ float bf_hi(unsigned w) { return __uint_as_float(w & 0xffff0000u); }
__device__ __forceinline__ void unpack8(const v4u r, float (&o)[8]) { o[0] = bf_lo(r.x); o[1] = bf_hi(r.x); o[2] = bf_lo(r.y); o[3] = bf_hi(r.y); o[4] = bf_lo(r.z); o[5] = bf_hi(r.z); o[6] = bf_lo(r.w); o[7] = bf_hi(r.w); }
__device__ __forceinline__ v4u pack8(const float (&o)[8]) { v4u w; w.x = pk2(o[0], o[1]); w.y = pk2(o[2], o[3]); w.z = pk2(o[4], o[5]); w.w = pk2(o[6], o[7]); return w; }
__device__ __forceinline__ float wave_sum(float v) {
#pragma unroll
    for (int o = 1; o < 64; o <<= 1) v += __shfl_xor(v, o);
    return v;
}
__device__ __forceinline__ float sum16(float v) {
#pragma unroll
    for (int o = 1; o < 16; o <<= 1) v += __shfl_xor(v, o);
    return v;
}
#define XB_TMO      128
#define XB_XCNT(j)  (256  + 64 * (j))
#define XB_XSUB(j)  (1280 + 64 * (j))
#define XB_XGEN(j)  (2304 + 64 * (j))
#define XB_TOP      3328
#define XB_TOPGEN   3392
#define XCD_BAR_WORDS 3456
#define XB_SPIN_CAP (1u << 18)

__device__ __forceinline__ unsigned xb_ld(unsigned* p)              { return __hip_atomic_load(p, __ATOMIC_RELAXED, __HIP_MEMORY_SCOPE_AGENT); }
__device__ __forceinline__ unsigned xb_add(unsigned* p, unsigned v) { return __hip_atomic_fetch_add(p, v, __ATOMIC_RELAXED, __HIP_MEMORY_SCOPE_AGENT); }
__device__ __forceinline__ unsigned xb_xcc_id() { return (unsigned)__builtin_amdgcn_s_getreg((3 << 11) | 20) & 0xFu; }
#define XB_SPIN(cond, bar) do { unsigned _sp = 0; while (cond) { __builtin_amdgcn_s_sleep(1); \
    if ((++_sp & 255u) == 0u) { if (xb_ld(&(bar)[XB_TMO])) break; if (_sp > XB_SPIN_CAP) { atomicAdd(&(bar)[XB_TMO], 1u); break; } } } } while (0)

struct XcdBarrier {
    unsigned* bar; unsigned x;
    volatile LAS unsigned* st;
};

__device__ __forceinline__ XcdBarrier xcd_barrier_post(unsigned* bar, volatile LAS unsigned* st) {
    XcdBarrier b; b.bar = bar; b.x = xb_xcc_id(); b.st = st;
    if (threadIdx.x == 0) (void)xb_add(&bar[XB_XCNT(b.x)], 1u);
    return b;
}
__device__ __forceinline__ void xcd_barrier_complete(unsigned* bar, unsigned x, unsigned& nloc, unsigned& nx) {
    const unsigned G = gridDim.x * gridDim.y * gridDim.z;
    unsigned sum, cnt, mine, sp = 0u;
    for (;;) {
        sum = 0u; cnt = 0u; mine = 0u;
#pragma unroll
        for (unsigned j = 0; j < 16; ++j) { const unsigned c = xb_ld(&bar[XB_XCNT(j)]); sum += c; cnt += (c > 0u) ? 1u : 0u; mine = (j == x) ? c : mine; }
        if (sum == G) break;
        __builtin_amdgcn_s_sleep(1);
        if ((++sp & 255u) == 0u) { if (xb_ld(&bar[XB_TMO])) break; if (sp > XB_SPIN_CAP) { atomicAdd(&bar[XB_TMO], 1u); break; } }
    }
    nloc = mine > 0u ? mine : 1u; nx = cnt > 0u ? cnt : 1u;
}

__device__ __forceinline__ void xcd_barrier(const XcdBarrier& b) {
    asm volatile("s_waitcnt vmcnt(0)" ::: "memory");
    __syncthreads();
    if (threadIdx.x == 0) {
        unsigned* bar = b.bar;
        __builtin_amdgcn_s_waitcnt(0);
        unsigned nloc = b.st[0], nx = b.st[1];
        if (nloc == 0u) { xcd_barrier_complete(bar, b.x, nloc, nx); b.st[0] = nloc; b.st[1] = nx; }
        const unsigned old = xb_add(&bar[XB_XSUB(b.x)], 1u);
        const unsigned gen = old / nloc;
        if (old + 1u == (gen + 1u) * nloc) {
            __builtin_amdgcn_fence(__ATOMIC_RELEASE, "agent");
            asm volatile("s_waitcnt vmcnt(0)" ::: "memory");
            const unsigned og = xb_add(&bar[XB_TOP], 1u);
            const unsigned tg = og / nx;
            if (og + 1u == (tg + 1u) * nx) xb_add(&bar[XB_TOPGEN], 1u);
            else XB_SPIN(xb_ld(&bar[XB_TOPGEN]) == tg, bar);
            __builtin_amdgcn_fence(__ATOMIC_ACQUIRE, "agent");
            xb_add(&bar[XB_XGEN(b.x)], 1u);
            asm volatile("s_waitcnt vmcnt(0)" ::: "memory");
        } else {
            XB_SPIN(xb_ld(&bar[XB_XGEN(b.x)]) == gen, bar);
            __builtin_amdgcn_fence(__ATOMIC_ACQUIRE, "agent");
            asm volatile("s_waitcnt vmcnt(0)" ::: "memory");
        }
    }
    __syncthreads();
}

__device__ __forceinline__ void transpose_item(const float* W, int K, int N, bf16* WT, int k0, int n0, int drow0, LAS float* scr, int lane) {
#pragma unroll 8
    for (int i = 0; i < 32; ++i) { const int kk = 2 * i + (lane >> 5); scr[kk * 33 + (lane & 31)] = W[(size_t)(k0 + kk) * N + n0 + (lane & 31)]; }
    LDS_WAIT(); asm volatile("" ::: "memory");
    const int c = lane & 7;
#pragma unroll
    for (int j = 0; j < 4; ++j) { const int n = (lane >> 3) + 8 * j; const LAS float* s = scr + (8 * c) * 33 + n;
        v4u o; o.x = pk2(s[0 * 33], s[1 * 33]); o.y = pk2(s[2 * 33], s[3 * 33]); o.z = pk2(s[4 * 33], s[5 * 33]); o.w = pk2(s[6 * 33], s[7 * 33]);
        *(v4u*)(WT + (size_t)(drow0 + n) * K + k0 + 8 * c) = o; }
    LDS_WAIT(); asm volatile("" ::: "memory");
}
__device__ __forceinline__ void prologue_phase(const float* w_in, const float* w_out, const float* w_gate, const float* w_up, const float* w_down, const float* lb_logits,
                                               unsigned char* ws, LAS unsigned char* lds, int gw, int NGW, int wave, int lane, int gtid) {
    LAS float* scr = (LAS float*)(lds + RING_OFF + wave * 16384);
    constexpr int I_IN = (D / 64) * (DIN / 32), I_OUT = (D / 64) * (D / 32), I_G = (D / 64) * (DFF / 32), I_DN = (DFF / 64) * (D / 32);
    constexpr int PER_LAYER = I_IN + I_OUT + 2 * I_G + I_DN, TOTAL = DEPTH * PER_LAYER;
    for (int it = gw; it < TOTAL; it += NGW) {
        const int l = it / PER_LAYER; int r = it % PER_LAYER;
        if (r < I_IN) { const int nb = r % (DIN / 32), kb = r / (DIN / 32);
            transpose_item(w_in + (size_t)l * D * DIN, D, DIN, (bf16*)(ws + WS_WIN + l * SZ_WIN), kb * 64, nb * 32, nb * 32, scr, lane); continue; } r -= I_IN;
        if (r < I_OUT) { const int nb = r % (D / 32), kb = r / (D / 32);
            transpose_item(w_out + (size_t)l * D * D, D, D, (bf16*)(ws + WS_WOUT + l * SZ_WOUT), kb * 64, nb * 32, nb * 32, scr, lane); continue; } r -= I_OUT;
        if (r < I_G) { const int nb = r % (DFF / 32), kb = r / (DFF / 32), n0 = nb * 32;
            transpose_item(w_gate + (size_t)l * D * DFF, D, DFF, (bf16*)(ws + WS_WGU + l * SZ_WGU), kb * 64, n0, (n0 >> 7) * 256 + (n0 & 127), scr, lane); continue; } r -= I_G;
        if (r < I_G) { const int nb = r % (DFF / 32), kb = r / (DFF / 32), n0 = nb * 32;
            transpose_item(w_up + (size_t)l * D * DFF, D, DFF, (bf16*)(ws + WS_WGU + l * SZ_WGU), kb * 64, n0, (n0 >> 7) * 256 + 128 + (n0 & 127), scr, lane); continue; } r -= I_G;
        { const int nb = r % (D / 32), kb = r / (D / 32);
            transpose_item(w_down + (size_t)l * DFF * D, DFF, D, (bf16*)(ws + WS_WDN + l * SZ_WDN), kb * 64, nb * 32, nb * 32, scr, lane); }
    }
    if (gtid < DH) {
        float lg[DEPTH], mx = -3.0e38f;
#pragma unroll
        for (int l = 0; l < DEPTH; ++l) { lg[l] = lb_logits[l * DH + gtid]; mx = fmaxf(mx, lg[l]); }
        float den = 0.f;
#pragma unroll
        for (int l = 0; l < DEPTH; ++l) { lg[l] = __expf(lg[l] - mx); den += lg[l]; }
        float* lbt = (float*)(ws + WS_LB); float cum = 0.f; const float p0 = lg[0] / den;
#pragma unroll
        for (int l = 0; l < DEPTH; ++l) { cum += lg[l] / den; lbt[l * DH + gtid] = fminf(fmaxf(cum - p0, 0.f), 1.0f - 1e-4f); }
    }
}
__device__ __forceinline__ void norm_phase(const float* x, const float* gain, bf16* out, int gw, int NGW, int lane) {
    f32x4 g[8];
#pragma unroll
    for (int j = 0; j < 8; ++j) g[j] = ((const f32x4*)gain)[lane + 64 * j];
    for (int m = gw; m < M; m += NGW) {
        const f32x4* xr = (const f32x4*)(x + (size_t)m * D) + lane;
        f32x4 v[8]; float s = 0.f;
#pragma unroll
        for (int j = 0; j < 8; ++j) { v[j] = xr[64 * j]; s += (v[j].x * v[j].x + v[j].y * v[j].y) + (v[j].z * v[j].z + v[j].w * v[j].w); }
        const float rs = 1.0f / sqrtf(wave_sum(s) * (1.0f / D) + EPS);
        v2u* o = (v2u*)(out + (size_t)m * D) + lane;
#pragma unroll
        for (int j = 0; j < 8; ++j) { const f32x4 y = v[j] * rs * g[j]; v2u w; w.x = pk2(y.x, y.y); w.y = pk2(y.z, y.w); o[64 * j] = w; }
    }
}
__device__ __forceinline__ void final_norm_phase(float* x, const float* gain, int gw, int NGW, int lane) {
    f32x4 g[8];
#pragma unroll
    for (int j = 0; j < 8; ++j) g[j] = ((const f32x4*)gain)[lane + 64 * j];
    for (int m = gw; m < M; m += NGW) {
        f32x4* xr = (f32x4*)(x + (size_t)m * D) + lane;
        f32x4 v[8]; float s = 0.f;
#pragma unroll
        for (int j = 0; j < 8; ++j) { v[j] = xr[64 * j]; s += (v[j].x * v[j].x + v[j].y * v[j].y) + (v[j].z * v[j].z + v[j].w * v[j].w); }
        const float rs = 1.0f / sqrtf(wave_sum(s) * (1.0f / D) + EPS);
#pragma unroll
        for (int j = 0; j < 8; ++j) xr[64 * j] = v[j] * rs * g[j];
    }
}
__device__ __forceinline__ void conv_phase(const bf16* proj, const float* cw, const float* gn, bf16* mixed, int gw, int NGW, int lane) {
    constexpr int R = 16, NSTRIP = M / R;
    float w0[2][8], w1[2][8], w2[2][8], gg[2][8];
#pragma unroll
    for (int i = 0; i < 2; ++i)
#pragma unroll
        for (int e = 0; e < 8; ++e) { const int c = i * 512 + lane * 8 + e; w0[i][e] = cw[c]; w1[i][e] = cw[DC + c]; w2[i][e] = cw[2 * DC + c]; gg[i][e] = gn[c]; }
    for (int strip = gw; strip < NSTRIP; strip += NGW) {
        const int m0 = strip * R, t0 = m0 % SEQ;
        float u1[2][8], u2[2][8];
#pragma unroll
        for (int i = 0; i < 2; ++i) {
            if (t0 == 0) {
#pragma unroll
                for (int e = 0; e < 8; ++e) { u1[i][e] = 0.f; u2[i][e] = 0.f; }
            } else {
                const bf16* p1 = proj + (size_t)(m0 - 1) * DIN + i * 512 + lane * 8; const bf16* p2 = p1 - DIN;
                float c1[8], h1[8], c2[8], h2[8];
                unpack8(*(const v4u*)(p1 + C_C), c1); unpack8(*(const v4u*)(p1 + C_H), h1); unpack8(*(const v4u*)(p2 + C_C), c2); unpack8(*(const v4u*)(p2 + C_H), h2);
#pragma unroll
                for (int e = 0; e < 8; ++e) { u1[i][e] = c1[e] * h1[e]; u2[i][e] = c2[e] * h2[e]; }
            }
        }
        for (int r = 0; r < R; ++r) {
            const size_t m = (size_t)(m0 + r);
#pragma unroll
            for (int i = 0; i < 2; ++i) {
                const bf16* p = proj + m * DIN + i * 512 + lane * 8;
                float bb[8], cc[8], hh[8], y[8]; unpack8(*(const v4u*)(p + C_B), bb); unpack8(*(const v4u*)(p + C_C), cc); unpack8(*(const v4u*)(p + C_H), hh);
                float ss = 0.f;
#pragma unroll
                for (int e = 0; e < 8; ++e) { const float u0 = cc[e] * hh[e]; y[e] = bb[e] * (w0[i][e] * u2[i][e] + w1[i][e] * u1[i][e] + w2[i][e] * u0); ss += y[e] * y[e]; u2[i][e] = u1[i][e]; u1[i][e] = u0; }
                const float rs = 1.0f / sqrtf(sum16(ss) * (1.0f / 128.0f) + EPS);
#pragma unroll
                for (int e = 0; e < 8; ++e) y[e] = y[e] * rs * gg[i][e];
                *(v4u*)(mixed + m * D + i * 512 + lane * 8) = pack8(y);
            }
        }
    }
}
__device__ __forceinline__ void hgrn_rec_phase(const bf16* proj, const float* lbl, bf16* mixed, LAS unsigned char* lds, int tid, int wave, int lane) {
    LAS float* F = (LAS float*)lds; LAS float* KK = F + 4096; LAS float* QS = KK + 4096; LAS float* V = QS + 4096; LAS float* PART = V + 2048;
    const int st = tid >> 4, sk = (tid & 15) * 8, sv = (tid & 15) * 4;
    for (int item = blockIdx.x; item < BATCH * HEADS * 2; item += gridDim.x) {
        const int b = item >> 4, h = (item >> 1) & 7, vh = item & 1;
        float lb[8];
#pragma unroll
        for (int e = 0; e < 8; ++e) lb[e] = lbl[h * HD + sk + e];
        float S[16];
#pragma unroll
        for (int j = 0; j < 16; ++j) S[j] = 0.f;
        const bf16* pq = proj + (size_t)(b * SEQ + st) * DIN + C_Q + h * HD + sk;
        const bf16* pz = proj + (size_t)(b * SEQ + st) * DIN + C_Z + h * HD + sk;
        const bf16* pi = proj + (size_t)(b * SEQ + st) * DIN + C_I + h * HD + vh * 64 + sv;
        v4u rq = *(const v4u*)pq, rz = *(const v4u*)pz; v2u ri = *(const v2u*)pi;
        for (int c = 0; c < SEQ / 32; ++c) {
            { float q[8], z[8], f[8], kk[8], qs[8]; unpack8(rq, q); unpack8(rz, z);
#pragma unroll
              for (int e = 0; e < 8; ++e) { const float t = __expf(-fabsf(z[e])), r = 1.0f / (1.0f + t), sp = r, sn = t * r;
                  const float sig = z[e] >= 0.f ? sp : sn, nsig = z[e] >= 0.f ? sn : sp; const float oml = 1.0f - lb[e];
                  f[e] = lb[e] + oml * sig; kk[e] = oml * nsig; qs[e] = pg8::silu_f(q[e]); }
              LAS f32x4* pf = (LAS f32x4*)(F + st * 128 + sk); pf[0] = (f32x4){f[0], f[1], f[2], f[3]}; pf[1] = (f32x4){f[4], f[5], f[6], f[7]};
              LAS f32x4* pk = (LAS f32x4*)(KK + st * 128 + sk); pk[0] = (f32x4){kk[0], kk[1], kk[2], kk[3]}; pk[1] = (f32x4){kk[4], kk[5], kk[6], kk[7]};
              LAS f32x4* ps = (LAS f32x4*)(QS + st * 128 + sk); ps[0] = (f32x4){qs[0], qs[1], qs[2], qs[3]}; ps[1] = (f32x4){qs[4], qs[5], qs[6], qs[7]};
              *(LAS f32x4*)(V + st * 64 + sv) = (f32x4){bf_lo(ri.x), bf_hi(ri.x), bf_lo(ri.y), bf_hi(ri.y)}; }
            __syncthreads();
            if (c + 1 < SEQ / 32) { const size_t o = (size_t)(c + 1) * 32 * DIN; rq = *(const v4u*)(pq + o); rz = *(const v4u*)(pz + o); ri = *(const v2u*)(pi + o); }
#pragma unroll 2
            for (int t = 0; t < 32; ++t) {
                const LAS f32x4* pf = (const LAS f32x4*)(F + t * 128 + wave * 16); const LAS f32x4* pk = (const LAS f32x4*)(KK + t * 128 + wave * 16); const LAS f32x4* ps = (const LAS f32x4*)(QS + t * 128 + wave * 16);
                const float vt = V[t * 64 + lane]; float p = 0.f;
#pragma unroll
                for (int i = 0; i < 4; ++i) { const f32x4 f = pf[i], k = pk[i], q = ps[i];
#pragma unroll
                    for (int e = 0; e < 4; ++e) { S[4 * i + e] = f[e] * S[4 * i + e] + k[e] * vt; p += q[e] * S[4 * i + e]; } }
                PART[(t * 8 + wave) * 64 + lane] = p;
            }
            __syncthreads();
            { f32x4 acc = (f32x4){0.f, 0.f, 0.f, 0.f};
#pragma unroll
              for (int w = 0; w < 8; ++w) acc += *(const LAS f32x4*)(PART + (st * 8 + w) * 64 + sv);
              v2u o; o.x = pk2(acc.x, acc.y); o.y = pk2(acc.z, acc.w);
              *(v2u*)(mixed + (size_t)(b * SEQ + c * 32 + st) * D + DC + h * HD + vh * 64 + sv) = o; }
        }
        __syncthreads();
    }
}
__device__ __forceinline__ void hgrn_fin_phase(const bf16* proj, const float* gn, bf16* mixed, int gw, int NGW, int lane) {
    float gg[2][8];
#pragma unroll
    for (int i = 0; i < 2; ++i)
#pragma unroll
        for (int e = 0; e < 8; ++e) gg[i][e] = gn[i * 512 + lane * 8 + e];
    for (int m = gw; m < M; m += NGW) {
#pragma unroll
        for (int i = 0; i < 2; ++i) {
            bf16* po = mixed + (size_t)m * D + DC + i * 512 + lane * 8;
            float o[8], g[8]; unpack8(*(const v4u*)po, o); unpack8(*(const v4u*)(proj + (size_t)m * DIN + C_G + i * 512 + lane * 8), g);
            float ss = 0.f;
#pragma unroll
            for (int e = 0; e < 8; ++e) ss += o[e] * o[e];
            const float rs = 1.0f / sqrtf(sum16(ss) * (1.0f / 128.0f) + EPS);
#pragma unroll
            for (int e = 0; e < 8; ++e) o[e] = o[e] * rs * gg[i][e] * pg8::silu_f(g[e]);
            *(v4u*)po = pack8(o);
        }
    }
}

struct Args { const float* in[13]; float* out; unsigned char* ws; int ph_lo, ph_hi; };
__global__ void __launch_bounds__(NTHR, 2) fwd(Args args) {
    extern __shared__ __attribute__((aligned(16))) unsigned char lds_raw[];
    LAS unsigned char* lds = (LAS unsigned char*)lds_raw;
    volatile LAS unsigned* MISC = (volatile LAS unsigned*)(lds + MISC_OFF);
    const int tid = threadIdx.x, lane = tid & 63, wave = __builtin_amdgcn_readfirstlane(tid >> 6);
    const int G = gridDim.x, bx = blockIdx.x, vcu = (G % 8 == 0) ? (bx % 8) * (G / 8) + bx / 8 : bx;
    const int gw = vcu * NWAVES + wave, NGW = G * NWAVES, gtid = vcu * NTHR + tid;
    unsigned char* ws = args.ws;
    unsigned* ctl = (unsigned*)(ws + WS_CTL);
    if (tid < 32) MISC[tid] = 0u;
    __syncthreads();
#if MK_ONE_LAUNCH
    XcdBarrier bar = xcd_barrier_post(ctl + CW_BAR, MISC + 8);
#define GRID_BAR() xcd_barrier(bar)
#else
#define GRID_BAR() do { } while (0)
#endif
    const float* x_in = args.in[0]; const float* norm_mix = args.in[1]; const float* w_in = args.in[2]; const float* conv_w = args.in[3]; const float* gn_conv = args.in[4];
    const float* lb_logits = args.in[5]; const float* gn_hgrn = args.in[6]; const float* w_out = args.in[7]; const float* norm_ffn = args.in[8];
    const float* w_gate = args.in[9]; const float* w_up = args.in[10]; const float* w_down = args.in[11]; const float* norm_final = args.in[12];
    float* out = args.out;
    bf16* HB = (bf16*)(ws + WS_HB); bf16* PROJ = (bf16*)(ws + WS_PROJ);
    const float* LBT = (const float*)(ws + WS_LB);
    const int lo = args.ph_lo, hi = args.ph_hi;
#define IN(k) (lo <= (k) && (k) < hi)
#define SEAM(k) do { if (IN((k) + 1)) GRID_BAR(); } while (0)

    if (IN(0)) { prologue_phase(w_in, w_out, w_gate, w_up, w_down, lb_logits, ws, lds, gw, NGW, wave, lane, gtid); SEAM(0); }
    for (int l = 0; l < DEPTH; ++l) {
        const int p = 1 + 8 * l;
        int tq = threadIdx.x; asm volatile("" : "+v"(tq));
        const int tid = tq, lane = tq & 63;
        const float* xs = (l == 0) ? x_in : out;
        if (IN(p + 0)) { norm_phase(xs, norm_mix + l * D, HB, gw, NGW, lane); SEAM(p + 0); }
        if (IN(p + 1)) {
            pg8::Gemm g{HB, (const bf16*)(ws + WS_WIN + l * SZ_WIN), M, DIN, D}; pg8::StaticOrder S; S.init(M, DIN, G, bx);
            pg8::EpiBf16Plain E{PROJ, DIN};
            pg8::gemm_phase<pg8::EpiBf16Plain, pg8::StaticOrder, true, true>(lds + RING_OFF, g, S, E);
            SEAM(p + 1); }
        if (IN(p + 2)) {
            hgrn_rec_phase(PROJ, LBT + l * DH, HB, lds + RING_OFF, tid, wave, lane);
            conv_phase(PROJ, conv_w + l * 3 * DC, gn_conv + l * DC, HB, gw, NGW, lane);
            SEAM(p + 2); }
        if (IN(p + 3)) { hgrn_fin_phase(PROJ, gn_hgrn + l * DH, HB, gw, NGW, lane); SEAM(p + 3); }
        if (IN(p + 4)) {
            pg8::Gemm g{HB, (const bf16*)(ws + WS_WOUT + l * SZ_WOUT), M, D, D}; pg8::StaticOrder S; S.init(M, D, G, bx);
            pg8::EpiResF32 E{xs, out, D};
            pg8::gemm_phase<pg8::EpiResF32, pg8::StaticOrder, true, true>(lds + RING_OFF, g, S, E);
            SEAM(p + 4); }
        if (IN(p + 5)) { norm_phase(out, norm_ffn + l * D, HB, gw, NGW, lane); SEAM(p + 5); }
        if (IN(p + 6)) {
            pg8::Gemm g{HB, (const bf16*)(ws + WS_WGU + l * SZ_WGU), M, NGU, D}; pg8::StaticOrder S; S.init(M, NGU, G, bx);
            pg8::EpiSwiGLU E{PROJ, DFF};
            pg8::gemm_phase<pg8::EpiSwiGLU, pg8::StaticOrder, true, true>(lds + RING_OFF, g, S, E);
            SEAM(p + 6); }
        if (IN(p + 7)) {
            pg8::Gemm g{PROJ, (const bf16*)(ws + WS_WDN + l * SZ_WDN), M, D, DFF}; pg8::StaticOrder S; S.init(M, D, G, bx);
            pg8::EpiResF32 E{out, out, D};
            pg8::gemm_phase<pg8::EpiResF32, pg8::StaticOrder, true, true>(lds + RING_OFF, g, S, E);
            SEAM(p + 7); }
    }
    if (IN(NPH - 1)) final_norm_phase(out, norm_final, gw, NGW, lane);
#undef IN
#undef SEAM
}

extern "C" void kernel_launch(void* const* d_in, const int* in_sizes, int n_in, void* d_out, int out_size, void* d_ws, size_t ws_size, hipStream_t stream) {
    static int grid = 0;
    if (grid == 0) {
        if (n_in != 13 || in_sizes[0] != M * D || out_size != M * D || ws_size < WS_END) { fprintf(stderr, "kernel_launch: unexpected shapes (n_in %d, in0 %d, out %d, ws %zu < %zu); nothing launched\n", n_in, n_in > 0 ? in_sizes[0] : -1, out_size, ws_size, (size_t)WS_END); grid = -1; return; }
        int dev = 0, cus = 0;
        if (hipGetDevice(&dev) != hipSuccess || hipDeviceGetAttribute(&cus, hipDeviceAttributeMultiprocessorCount, dev) != hipSuccess) { grid = -1; return; }
        if (hipFuncSetAttribute((const void*)fwd, hipFuncAttributeMaxDynamicSharedMemorySize, LDS_BYTES) != hipSuccess) { fprintf(stderr, "kernel_launch: hipFuncSetAttribute failed\n"); grid = -1; return; }
        (void)hipGetLastError();
        grid = cus;
    }
    if (grid < 0) return;
    (void)hipMemsetAsync((char*)d_ws + WS_CTL, 0, CTL_ZERO_BYTES, stream);
    Args a{};
    for (int i = 0; i < 13; ++i) a.in[i] = (const float*)d_in[i];
    a.out = (float*)d_out; a.ws = (unsigned char*)d_ws;
#if MK_ONE_LAUNCH
    a.ph_lo = 0; a.ph_hi = NPH;
    hipLaunchKernelGGL(fwd, dim3(grid), dim3(NTHR), LDS_BYTES, stream, a);
#else
    for (int p = 0; p < NPH; ++p) { a.ph_lo = p; a.ph_hi = p + 1; hipLaunchKernelGGL(fwd, dim3(grid), dim3(NTHR), LDS_BYTES, stream, a); }
#endif
}
```

```cpp
#include <hip/hip_runtime.h>
#include <cstdio>
#include <cstdint>
#define MK_ONE_LAUNCH 1
#define PG8_WGM 4
#ifndef RELAX_EPI
#define RELAX_EPI 1
#endif
#ifndef PG8_WGM
#define PG8_WGM 8
#endif
#ifndef PG8_SP2V
#define PG8_SP2V true
#endif
#ifndef TPROBE
#define TPROBE 0
#endif
namespace pg8 {
#define PG8_LAS __attribute__((address_space(3)))
typedef unsigned short bf16_t;
typedef short bf16x8 __attribute__((ext_vector_type(8)));
typedef float f32x4 __attribute__((ext_vector_type(4)));
typedef unsigned u32x4 __attribute__((ext_vector_type(4)));
constexpr int BM = 256, BK = 64, HALF = 128, HTB = HALF * BK * 2  , STAGE_BYTES = 8 * HTB, NXCD = 8, WGM = PG8_WGM;

__host__ __device__ __forceinline__ int lds_byte(int r, int c) { const int st = (r >> 4) * 2 + (c >> 5), rr = r & 15, cc = c & 31, ob = rr * 64 + cc * 2; return st * 1024 + (ob ^ (((ob >> 9) & 1) << 5)); }
__host__ __device__ __forceinline__ void stage_rc(int b, int& R, int& C) { const int st = b / 1024, sb = b % 1024, swz = sb ^ (((sb >> 9) & 1) << 5); R = (st >> 1) * 16 + swz / 64; C = (st & 1) * 32 + (swz % 64) / 2; }
__host__ __device__ __forceinline__ int perm32(int rho) { const int n = rho >> 4, i = rho & 15; return 8 * (i >> 2) + 4 * n + (i & 3); }

struct Unit { int pm, pn; };
struct Gemm { const bf16_t* A; const bf16_t* Bt; int M, N, K, lda; };

struct StaticOrder {
    int nM, nN, nwg, G, c; int fixed = 0;
    __host__ __device__ void init(int M, int N, int G_, int c_) { nM = M / BM; nN = N / BM; nwg = nM * nN; G = G_; c = c_; }
    __host__ __device__ bool next(int i, Unit& u) const {
        if (fixed) { if (i >= fixed) return false; u.pm = 0; u.pn = 0; return true; }
        const long L = (long)i * G + c; if (L >= nwg) return false;
        int wgid = (int)L; { const int q = nwg / NXCD, r = nwg % NXCD, xcd = wgid % NXCD, off = wgid / NXCD; wgid = (xcd < r ? xcd * (q + 1) : r * (q + 1) + (xcd - r) * q) + off; }
        const int nig = WGM * nN, gid = wgid / nig, fm = gid * WGM, gsz = (nM - fm) < WGM ? (nM - fm) : WGM;
        u.pm = fm + ((wgid % nig) % gsz); u.pn = (wgid % nig) / gsz; return true;
    }
    __device__ __forceinline__ void a_ready(const Unit&) const {}
    __device__ __forceinline__ void done(const Unit&) const {}
};

__device__ __forceinline__ unsigned cvt_pk_bf16(float lo, float hi) { unsigned r; asm volatile("v_cvt_pk_bf16_f32 %0, %1, %2" : "=v"(r) : "v"(lo), "v"(hi)); return r; }
typedef float f32x2 __attribute__((ext_vector_type(2)));
#if defined(NT_STORES) && NT_STORES
#define ST16(p, v) __builtin_nontemporal_store((v), (u32x4*)(p))
#else
#define ST16(p, v) (*(u32x4*)(p) = (v))
#endif
__device__ __forceinline__ float silu_f(float x) { return x * __builtin_amdgcn_rcpf(1.0f + __builtin_amdgcn_exp2f(-1.44269504089f * x)); }
__device__ __forceinline__ void row_scale_table(const float* ss, PG8_LAS float* RS, int pm, int t) {
    const int tag = __builtin_amdgcn_readfirstlane(__float_as_int(RS[0]));
    if (tag != pm + 1) {
        asm volatile("s_waitcnt lgkmcnt(0)" ::: "memory"); __builtin_amdgcn_s_barrier(); asm volatile("" ::: "memory");
        if (t < BM) { const f32x4* p = (const f32x4*)(ss + (size_t)(pm * BM + t) * 8); const f32x4 a = p[0], b = p[1];
            RS[4 + t] = 1.0f / __builtin_sqrtf((((a[0] + a[1]) + (a[2] + a[3])) + ((b[0] + b[1]) + (b[2] + b[3]))) * (1.0f / 2048.0f) + 1e-6f);
            if (t == 0) RS[0] = __int_as_float(pm + 1); }
        asm volatile("s_waitcnt lgkmcnt(0)" ::: "memory"); __builtin_amdgcn_s_barrier(); asm volatile("" ::: "memory");
    }
}
struct EpiBf16Plain {
    static constexpr bool PERM = true, AFTER_DRAIN = false; static constexpr int NST = 16;
    bf16_t* O; int ldc;
    __device__ __forceinline__ void operator()(const f32x4 (&acc)[2][2][4][2], const Unit& u, int wr, int wc, int fr, int fq) const {
        const int row0 = u.pm * BM + wr * 64 + fr, col0 = u.pn * BM + wc * 32 + 8 * fq;
#pragma unroll
        for (int ai = 0; ai < 2; ++ai)
#pragma unroll
            for (int m = 0; m < 4; ++m) { bf16_t* rowp = O + (size_t)(row0 + ai * HALF + m * 16) * ldc + col0;
#pragma unroll
                for (int bj = 0; bj < 2; ++bj) { const f32x4 v0 = acc[ai][bj][m][0], v1 = acc[ai][bj][m][1];
                    u32x4 w; w.x = cvt_pk_bf16(v0[0], v0[1]); w.y = cvt_pk_bf16(v0[2], v0[3]); w.z = cvt_pk_bf16(v1[0], v1[1]); w.w = cvt_pk_bf16(v1[2], v1[3]);
                    *(u32x4*)(rowp + bj * HALF) = w; } }
    }
};
struct EpiProj {
    static constexpr bool PERM = true, AFTER_DRAIN = false; static constexpr int NST = 16;
    bf16_t* O; int ldc; const float* lbt; const float* ss; PG8_LAS float* RS;
    __device__ __forceinline__ void operator()(const f32x4 (&acc)[2][2][4][2], const Unit& u, int wr, int wc, int fr, int fq) const {
        const int row0 = u.pm * BM + wr * 64 + fr, col0 = u.pn * BM + wc * 32 + 8 * fq, kind = u.pn >> 2;
        row_scale_table(ss, RS, u.pm, (wr * 4 + wc) * 64 + fq * 16 + fr);
        f32x4 lbv[2][2];
        if (kind == 4) {
#pragma unroll
            for (int bj = 0; bj < 2; ++bj)
#pragma unroll
                for (int n = 0; n < 2; ++n) lbv[bj][n] = *(const f32x4*)(lbt + (col0 - 4096) + bj * HALF + 4 * n);
        }
#pragma unroll
        for (int ai = 0; ai < 2; ++ai) { float rs[4];
#pragma unroll
            for (int m = 0; m < 4; ++m) rs[m] = RS[4 + ai * HALF + wr * 64 + m * 16 + fr];
#pragma unroll
            for (int m = 0; m < 4; ++m) { bf16_t* rowp = O + (size_t)(row0 + ai * HALF + m * 16) * ldc + col0;
#pragma unroll
                for (int bj = 0; bj < 2; ++bj) { f32x4 v[2] = {acc[ai][bj][m][0] * rs[m], acc[ai][bj][m][1] * rs[m]};
                    if (kind == 3 || kind == 6) {
#pragma unroll
                        for (int n = 0; n < 2; ++n)
#pragma unroll
                            for (int j = 0; j < 4; ++j) v[n][j] = silu_f(v[n][j]);
                    } else if (kind == 4) {
#pragma unroll
                        for (int n = 0; n < 2; ++n)
#pragma unroll
                            for (int j = 0; j < 4; ++j) { const float z = v[n][j], t = __builtin_amdgcn_exp2f(-1.44269504089f * __builtin_fabsf(z)), ri = __builtin_amdgcn_rcpf(1.0f + t);
                                const float sig = z >= 0.f ? ri : t * ri, lb = lbv[bj][n][j]; v[n][j] = __builtin_amdgcn_logf(__builtin_fmaxf(lb + (1.0f - lb) * sig, 1e-30f)); }
                    }
                    u32x4 w; w.x = cvt_pk_bf16(v[0][0], v[0][1]); w.y = cvt_pk_bf16(v[0][2], v[0][3]); w.z = cvt_pk_bf16(v[1][0], v[1][1]); w.w = cvt_pk_bf16(v[1][2], v[1][3]);
                    ST16(rowp + bj * HALF, w); } } }
    }
};
struct EpiResBf16 {
    static constexpr bool PERM = true, AFTER_DRAIN = false; static constexpr int NST = 16;
    const bf16_t* res; bf16_t* out; int ldc; float* ss; PG8_LAS float* P;
    __device__ __forceinline__ void operator()(const f32x4 (&acc)[2][2][4][2], const Unit& u, int wr, int wc, int fr, int fq) const {
        const int row0 = u.pm * BM + wr * 64 + fr, col0 = u.pn * BM + wc * 32 + 8 * fq;
#pragma unroll
        for (int ai = 0; ai < 2; ++ai) {
            u32x4 r[4][2];
#pragma unroll
            for (int m = 0; m < 4; ++m)
#pragma unroll
                for (int bj = 0; bj < 2; ++bj) r[m][bj] = *(const u32x4*)(res + (size_t)(row0 + ai * HALF + m * 16) * ldc + col0 + bj * HALF);
            asm volatile("" ::: "memory");
#pragma unroll
            for (int m = 0; m < 4; ++m) { float s = 0.f;
#pragma unroll
                for (int bj = 0; bj < 2; ++bj) { const u32x4 q = r[m][bj]; const f32x4 a0 = acc[ai][bj][m][0], a1 = acc[ai][bj][m][1]; u32x4 w;
                    w.x = cvt_pk_bf16(__uint_as_float(q.x << 16) + a0[0], __uint_as_float(q.x & 0xffff0000u) + a0[1]); w.y = cvt_pk_bf16(__uint_as_float(q.y << 16) + a0[2], __uint_as_float(q.y & 0xffff0000u) + a0[3]);
                    w.z = cvt_pk_bf16(__uint_as_float(q.z << 16) + a1[0], __uint_as_float(q.z & 0xffff0000u) + a1[1]); w.w = cvt_pk_bf16(__uint_as_float(q.w << 16) + a1[2], __uint_as_float(q.w & 0xffff0000u) + a1[3]);
                    *(u32x4*)(out + (size_t)(row0 + ai * HALF + m * 16) * ldc + col0 + bj * HALF) = w;
#pragma unroll
                    for (int e = 0; e < 4; ++e) { const float lo = __uint_as_float(w[e] << 16), hi = __uint_as_float(w[e] & 0xffff0000u); s += lo * lo + hi * hi; } }
                s += __shfl_xor(s, 16); s += __shfl_xor(s, 32);
                if (fq == 0) P[(ai * HALF + wr * 64 + m * 16 + fr) * 4 + wc] = s; }
            asm volatile("" ::: "memory");
        }
        asm volatile("s_waitcnt lgkmcnt(0)" ::: "memory"); __builtin_amdgcn_s_barrier(); asm volatile("" ::: "memory");
        const int t = (wr * 4 + wc) * 64 + fq * 16 + fr;
        if (t < BM) { const f32x4 p = *(const PG8_LAS f32x4*)(P + t * 4); ss[(size_t)(u.pm * BM + t) * 8 + u.pn] = (p[0] + p[1]) + (p[2] + p[3]); }
    }
};
struct EpiSwiGLU {
    static constexpr bool PERM = true, AFTER_DRAIN = false; static constexpr int NST = 8;
    bf16_t* H; int ldh; const float* ss; PG8_LAS float* RS;
    __device__ __forceinline__ void operator()(const f32x4 (&acc)[2][2][4][2], const Unit& u, int wr, int wc, int fr, int fq) const {
        const int row0 = u.pm * BM + wr * 64 + fr, col0 = u.pn * HALF + wc * 32 + 8 * fq;
        row_scale_table(ss, RS, u.pm, (wr * 4 + wc) * 64 + fq * 16 + fr);
#pragma unroll
        for (int ai = 0; ai < 2; ++ai) { float rs[4];
#pragma unroll
            for (int m = 0; m < 4; ++m) rs[m] = RS[4 + ai * HALF + wr * 64 + m * 16 + fr];
#pragma unroll
            for (int m = 0; m < 4; ++m) { bf16_t* rowp = H + (size_t)(row0 + ai * HALF + m * 16) * ldh + col0;
                const f32x4 g0 = acc[ai][0][m][0] * rs[m], g1 = acc[ai][0][m][1] * rs[m], u0 = acc[ai][1][m][0] * rs[m], u1 = acc[ai][1][m][1] * rs[m];
                u32x4 w; w.x = cvt_pk_bf16(silu_f(g0[0]) * u0[0], silu_f(g0[1]) * u0[1]); w.y = cvt_pk_bf16(silu_f(g0[2]) * u0[2], silu_f(g0[3]) * u0[3]);
                w.z = cvt_pk_bf16(silu_f(g1[0]) * u1[0], silu_f(g1[1]) * u1[1]); w.w = cvt_pk_bf16(silu_f(g1[2]) * u1[2], silu_f(g1[3]) * u1[3]);
                ST16(rowp, w); } }
    }
};

template <class Epi, class Sched, bool ALIGN_EPI = false, bool SP2 = false>
__device__ __forceinline__ void gemm_phase(PG8_LAS unsigned char* lds, const Gemm g, const Sched& S, const Epi& E, unsigned long long& gp_acc) {
    unsigned long long gp_t0 = 0; (void)gp_t0; (void)gp_acc;
#define GP_B(k) do { if (TPROBE == (k)) gp_t0 = __builtin_amdgcn_s_memrealtime(); } while (0)
#define GP_E(k) do { if (TPROBE == (k)) gp_acc += __builtin_amdgcn_s_memrealtime() - gp_t0; } while (0)
    int tid_ = threadIdx.x; asm volatile("" : "+v"(tid_));
    const int tid = tid_, wid = __builtin_amdgcn_readfirstlane(tid >> 6), lane = tid & 63, wr = wid >> 2, wc = wid & 3, fr = lane & 15, fq = lane >> 4;
    const int K = g.K, nt = K / BK;
    unsigned voffA[2], voffB[2];
#pragma unroll
    for (int i = 0; i < 2; ++i) { int R, C; stage_rc(tid * 16 + i * 8192, R, C); const int Rb = Epi::PERM ? ((R & ~31) + perm32(R & 31)) : R;
        voffA[i] = (unsigned)(R * g.lda + C) * 2u; voffB[i] = (unsigned)(Rb * K + C) * 2u; }
    const size_t kstep = (size_t)(BK * 2);
    const size_t hstep = (size_t)HALF * K * 2;
    const size_t hstepA = (size_t)HALF * g.lda * 2, tstepA = 2 * hstepA;
    const size_t tstep = 2 * hstep;
    const unsigned ldsw = (unsigned)wid * 1024u;
    const int aoff = lds_byte(wr * 64 + fr, fq * 8), boff = lds_byte(wc * 32 + fr, fq * 8);
#define PG8_SA(b, h) (((b) * 2 + (h)) * HTB)
#define PG8_SB(b, h) ((4 + (b) * 2 + (h)) * HTB)
#define PG8_STAGE(bufoff, gbase, voff) do { _Pragma("unroll") for (int _i = 0; _i < 2; ++_i) \
        __builtin_amdgcn_global_load_lds((const unsigned*)((const char*)(gbase) + (voff)[_i]), (PG8_LAS unsigned*)(lds + (bufoff) + ldsw + _i * 8192), 16, 0, 0); } while (0)
#define PG8_LDA(dst, b, h) do { _Pragma("unroll") for (int m = 0; m < 4; ++m) _Pragma("unroll") for (int k = 0; k < 2; ++k) dst[m][k] = *(const PG8_LAS bf16x8*)(lds + PG8_SA(b, h) + aoff + m * 2048 + k * 1024); } while (0)
#define PG8_LDB(dst, b, h) do { _Pragma("unroll") for (int n = 0; n < 2; ++n) _Pragma("unroll") for (int k = 0; k < 2; ++k) dst[n][k] = *(const PG8_LAS bf16x8*)(lds + PG8_SB(b, h) + boff + n * 2048 + k * 1024); } while (0)
#define PG8_MMA(ai, bj, At, Bt) do { __builtin_amdgcn_s_setprio(1); _Pragma("unroll") for (int m = 0; m < 4; ++m) _Pragma("unroll") for (int n = 0; n < 2; ++n) _Pragma("unroll") for (int k = 0; k < 2; ++k) \
        acc[ai][bj][m][n] = __builtin_amdgcn_mfma_f32_16x16x32_bf16(Bt[n][k], At[m][k], acc[ai][bj][m][n], 0, 0, 0); __builtin_amdgcn_s_setprio(0); } while (0)
#define PG8_WAIT_V(n) asm volatile("s_waitcnt vmcnt(" #n ")" ::: "memory")
#define PG8_WAIT_V8R do { if constexpr (Epi::NST == 16) asm volatile("s_waitcnt vmcnt(24)\n\ts_cmp_lg_u32 %0, 0\n\ts_cbranch_scc1 1f\n\ts_waitcnt vmcnt(8)\n1:" :: "s"(relax) : "memory", "scc"); \
        else if constexpr (Epi::NST == 8) asm volatile("s_waitcnt vmcnt(16)\n\ts_cmp_lg_u32 %0, 0\n\ts_cbranch_scc1 1f\n\ts_waitcnt vmcnt(8)\n1:" :: "s"(relax) : "memory", "scc"); \
        else asm volatile("s_waitcnt vmcnt(8)" ::: "memory"); } while (0)
#define PG8_WAIT_L(n) asm volatile("s_waitcnt lgkmcnt(" #n ")" ::: "memory")
#define PG8_BAR __builtin_amdgcn_s_barrier()
#define PG8_SCHED __builtin_amdgcn_sched_barrier(0)
    Unit cur, nxt; int ui = 0;
    if (!S.next(0, cur)) return;
    f32x4 acc[2][2][4][2];
#pragma unroll
    for (int a = 0; a < 2; ++a)
#pragma unroll
        for (int b = 0; b < 2; ++b)
#pragma unroll
            for (int m = 0; m < 4; ++m)
#pragma unroll
                for (int n = 0; n < 2; ++n) acc[a][b][m][n] = (f32x4){0.f, 0.f, 0.f, 0.f};
    bf16x8 At[4][2], B0[2][2], B1[2][2];
    const char* cA = (const char*)g.A + (size_t)cur.pm * tstepA; const char* cB = (const char*)g.Bt + (size_t)cur.pn * tstep;
    S.a_ready(cur);
    if constexpr (SP2) {
        PG8_STAGE(PG8_SB(0, 0), cB, voffB); PG8_STAGE(PG8_SB(0, 1), cB + hstep, voffB); PG8_STAGE(PG8_SA(0, 0), cA, voffA); PG8_STAGE(PG8_SA(0, 1), cA + hstepA, voffA);
        if (wr == 1) PG8_BAR;
        PG8_WAIT_V(2); PG8_BAR;
        PG8_STAGE(PG8_SB(1, 0), cB + kstep, voffB); PG8_STAGE(PG8_SA(1, 0), cA + kstep, voffA); PG8_STAGE(PG8_SB(1, 1), cB + hstep + kstep, voffB);
        PG8_WAIT_V(6); PG8_BAR;
    } else {
        PG8_STAGE(PG8_SB(0, 0), cB, voffB); PG8_STAGE(PG8_SA(0, 0), cA, voffA); PG8_STAGE(PG8_SB(0, 1), cB + hstep, voffB); PG8_STAGE(PG8_SA(0, 1), cA + hstepA, voffA);
        if (wr == 1) PG8_BAR;
        PG8_WAIT_V(4); PG8_BAR;
        PG8_STAGE(PG8_SB(1, 0), cB + kstep, voffB); PG8_STAGE(PG8_SA(1, 0), cA + kstep, voffA); PG8_STAGE(PG8_SB(1, 1), cB + hstep + kstep, voffB);
        PG8_WAIT_V(6); PG8_BAR;
    }
    for (;;) {
        const bool has_next = S.next(ui + 1, nxt);
        const char* nA = has_next ? (const char*)g.A + (size_t)nxt.pm * tstepA : cA; const char* nB = has_next ? (const char*)g.Bt + (size_t)nxt.pn * tstep : cB;
        for (int t = 0; t < nt; t += 2) {
            const bool last = (t == nt - 2); const int relax = __builtin_amdgcn_readfirstlane((RELAX_EPI && (t == 0) && (ui > 0)) ? 1 : 0);
            const char* a1 = cA + (size_t)(t + 1) * kstep;
            const char* a2 = last ? nA : cA + (size_t)(t + 2) * kstep; const char* b2 = last ? nB : cB + (size_t)(t + 2) * kstep;
            const char* a3 = a2 + kstep; const char* b3 = b2 + kstep;
            if (last && has_next) S.a_ready(nxt);
            if (t == 0) GP_B(21); GP_B(22);
            if constexpr (SP2) {
            PG8_LDB(B0, 0, 0); PG8_LDB(B1, 0, 1); PG8_SCHED; PG8_LDA(At, 0, 0); PG8_STAGE(PG8_SA(1, 1), a1 + hstepA, voffA);
            PG8_WAIT_V8R; PG8_WAIT_L(0); PG8_BAR; PG8_MMA(0, 0, At, B0); PG8_MMA(0, 1, At, B1); PG8_BAR; PG8_SCHED;
            PG8_LDA(At, 0, 1); PG8_STAGE(PG8_SB(0, 0), b2, voffB); PG8_STAGE(PG8_SB(0, 1), b2 + hstep, voffB); PG8_STAGE(PG8_SA(0, 0), a2, voffA);
            PG8_WAIT_V8R; PG8_WAIT_L(0); PG8_BAR; PG8_MMA(1, 0, At, B0); PG8_MMA(1, 1, At, B1); PG8_BAR; PG8_SCHED;
            PG8_LDB(B0, 1, 0); PG8_LDB(B1, 1, 1); PG8_SCHED; PG8_LDA(At, 1, 0); PG8_STAGE(PG8_SA(0, 1), a2 + hstepA, voffA);
            PG8_WAIT_V(8); PG8_WAIT_L(0); PG8_BAR; PG8_MMA(0, 0, At, B0); PG8_MMA(0, 1, At, B1); PG8_BAR; PG8_SCHED;
            PG8_LDA(At, 1, 1); PG8_STAGE(PG8_SB(1, 0), b3, voffB); PG8_STAGE(PG8_SB(1, 1), b3 + hstep, voffB); PG8_STAGE(PG8_SA(1, 0), a3, voffA);
            PG8_WAIT_V(8); PG8_WAIT_L(0); PG8_BAR; PG8_MMA(1, 0, At, B0); PG8_MMA(1, 1, At, B1); PG8_BAR; PG8_SCHED;
            } else {
            PG8_LDB(B0, 0, 0); PG8_SCHED; PG8_LDA(At, 0, 0); PG8_STAGE(PG8_SA(1, 1), a1 + hstepA, voffA);
            PG8_WAIT_L(8); PG8_BAR; PG8_WAIT_L(0); PG8_MMA(0, 0, At, B0); PG8_BAR; PG8_SCHED;
            PG8_LDB(B1, 0, 1); PG8_STAGE(PG8_SB(0, 0), b2, voffB);
            PG8_BAR; PG8_WAIT_L(0); PG8_MMA(0, 1, At, B1); PG8_BAR;
            PG8_LDA(At, 0, 1); PG8_STAGE(PG8_SA(0, 0), a2, voffA);
            PG8_BAR; PG8_WAIT_L(0); PG8_MMA(1, 0, At, B0); PG8_BAR; PG8_SCHED;
            PG8_STAGE(PG8_SB(0, 1), b2 + hstep, voffB);
            PG8_WAIT_V(6); PG8_BAR; PG8_MMA(1, 1, At, B1); PG8_BAR;
            PG8_LDB(B0, 1, 0); PG8_SCHED; PG8_LDA(At, 1, 0); PG8_STAGE(PG8_SA(0, 1), a2 + hstepA, voffA);
            PG8_WAIT_L(8); PG8_BAR; PG8_WAIT_L(0); PG8_MMA(0, 0, At, B0); PG8_BAR; PG8_SCHED;
            PG8_LDB(B1, 1, 1); PG8_STAGE(PG8_SB(1, 0), b3, voffB);
            PG8_BAR; PG8_WAIT_L(0); PG8_MMA(0, 1, At, B1); PG8_BAR;
            PG8_LDA(At, 1, 1); PG8_STAGE(PG8_SA(1, 0), a3, voffA);
            PG8_BAR; PG8_WAIT_L(0); PG8_MMA(1, 0, At, B0); PG8_BAR; PG8_SCHED;
            PG8_STAGE(PG8_SB(1, 1), b3 + hstep, voffB);
            PG8_WAIT_V(6); PG8_BAR; PG8_MMA(1, 1, At, B1); PG8_BAR;
            }
            if (t == 0) GP_E(21); GP_E(22);
        }
        if constexpr (ALIGN_EPI) { if (wr == 0) PG8_BAR; }
        GP_B(20);
        if constexpr (!Epi::AFTER_DRAIN) { E(acc, cur, wr, wc, fr, fq);
#if defined(DUP_EPI) && DUP_EPI
            if constexpr (Epi::PERM) { asm volatile("" ::: "memory"); E(acc, cur, wr, wc, fr, fq); }
#endif
            S.done(cur); }
        GP_E(20);
        if (!has_next) break;
#pragma unroll
        for (int a = 0; a < 2; ++a)
#pragma unroll
            for (int b = 0; b < 2; ++b)
#pragma unroll
                for (int m = 0; m < 4; ++m)
#pragma unroll
                    for (int n = 0; n < 2; ++n) acc[a][b][m][n] = (f32x4){0.f, 0.f, 0.f, 0.f};
        cur = nxt; cA = nA; cB = nB; ++ui;
        if constexpr (ALIGN_EPI) { if (wr == 1) PG8_BAR; }
    }
    PG8_WAIT_V(0);
    if constexpr (!ALIGN_EPI) { if (wr == 0) PG8_BAR; }
    PG8_BAR;
    if constexpr (Epi::AFTER_DRAIN) { E.fused(acc, cur, wr, wc, fr, fq, lds, wid, lane); S.done(cur); }
#undef PG8_SA
#undef PG8_SB
#undef PG8_STAGE
#undef PG8_LDA
#undef PG8_LDB
#undef PG8_MMA
#undef PG8_WAIT_V
#undef PG8_WAIT_V8R
#undef PG8_WAIT_L
#undef PG8_BAR
#undef PG8_SCHED
#undef GP_B
#undef GP_E
}
}

constexpr int NWAVES = 8, NTHR = 512;
constexpr int D = 2048, BATCH = 16, SEQ = 2048, M = BATCH * SEQ, DEPTH = 4;
constexpr int DC = 1024, DH = 1024, DIN = 7168, DFF = 5632, NGU = 2 * DFF, HEADS = 8, HD = 128;
constexpr int C_B = 0, C_C = 1024, C_H = 2048, C_Q = 3072, C_Z = 4096, C_I = 5120, C_G = 6144;
constexpr float EPS = 1e-6f;
#ifndef MK_ONE_LAUNCH
#define MK_ONE_LAUNCH 1
#endif
constexpr int NPH = 2 + 5 * DEPTH;

constexpr size_t MiB = 1u << 20;
constexpr size_t WS_CTL = 0, CTL_ZERO_BYTES = 1 * MiB;
constexpr size_t WS_LB = 1 * MiB;
constexpr size_t WS_SS = 2 * MiB;
constexpr size_t WS_WIN = 3 * MiB, SZ_WIN = (size_t)DIN * D * 2;
constexpr size_t WS_WOUT = WS_WIN + DEPTH * SZ_WIN, SZ_WOUT = (size_t)D * D * 2;
constexpr size_t WS_WGU = WS_WOUT + DEPTH * SZ_WOUT, SZ_WGU = (size_t)NGU * D * 2;
constexpr size_t WS_WDN = WS_WGU + DEPTH * SZ_WGU, SZ_WDN = (size_t)D * DFF * 2;
constexpr size_t WS_HB = WS_WDN + DEPTH * SZ_WDN;
constexpr size_t WS_PROJ = WS_HB + (size_t)M * D * 2;
constexpr size_t WS_END = WS_PROJ + (size_t)M * DIN * 2;
constexpr int CW_BAR = 4096;

constexpr int RING_OFF = 0, RING_BYTES = 131072;
constexpr int MISC_OFF = RING_BYTES + 320;
constexpr int RST_OFF = RING_BYTES + 8192;
constexpr int PSS_OFF = RING_BYTES + 1024;
constexpr int LDS_BYTES = 147456;

#define GAS __attribute__((address_space(1)))
#define LAS __attribute__((address_space(3)))
typedef unsigned short bf16;
typedef unsigned v4u __attribute__((ext_vector_type(4)));
typedef unsigned v2u __attribute__((ext_vector_type(2)));
typedef float f32x4 __attribute__((ext_vector_type(4)));
#define LDS_WAIT() asm volatile("s_waitcnt lgkmcnt(0)" ::: "memory")
#define VM_WAIT() asm volatile("s_waitcnt vmcnt(0)" ::: "memory")
__device__ __forceinline__ unsigned pk2(float lo, float hi) { return pg8::cvt_pk_bf16(lo, hi); }
__device__ __forceinline__ float bf_lo(unsigned w) { return __uint_as_float(w << 16); }
__device__ __forceinline__ float bf_hi(unsigned w) { return __uint_as_float(w & 0xffff0000u); }
__device__ __forceinline__ void unpack8(const v4u r, float (&o)[8]) { o[0] = bf_lo(r.x); o[1] = bf_hi(r.x); o[2] = bf_lo(r.y); o[3] = bf_hi(r.y); o[4] = bf_lo(r.z); o[5] = bf_hi(r.z); o[6] = bf_lo(r.w); o[7] = bf_hi(r.w); }
__device__ __forceinline__ v4u pack8(const float (&o)[8]) { v4u w; w.x = pk2(o[0], o[1]); w.y = pk2(o[2], o[3]); w.z = pk2(o[4], o[5]); w.w = pk2(o[6], o[7]); return w; }
__device__ __forceinline__ float wave_sum(float v) {
#pragma unroll
    for (int o = 1; o < 64; o <<= 1) v += __shfl_xor(v, o);
    return v;
}
__device__ __forceinline__ float sum16(float v) {
#pragma unroll
    for (int o = 1; o < 16; o <<= 1) v += __shfl_xor(v, o);
    return v;
}
#define XB_TMO      128
#define XB_XCNT(j)  (256  + 64 * (j))
#define XB_XSUB(j)  (1280 + 64 * (j))
#define XB_XGEN(j)  (2304 + 64 * (j))
#define XB_TOP      3328
#define XB_TOPGEN   3392
#define XCD_BAR_WORDS 3456
#define XB_SPIN_CAP (1u << 18)

__device__ __forceinline__ unsigned xb_ld(unsigned* p)              { return __hip_atomic_load(p, __ATOMIC_RELAXED, __HIP_MEMORY_SCOPE_AGENT); }
__device__ __forceinline__ unsigned xb_add(unsigned* p, unsigned v) { return __hip_atomic_fetch_add(p, v, __ATOMIC_RELAXED, __HIP_MEMORY_SCOPE_AGENT); }
__device__ __forceinline__ unsigned xb_xcc_id() { return (unsigned)__builtin_amdgcn_s_getreg((3 << 11) | 20) & 0xFu; }
#define XB_SPIN(cond, bar) do { unsigned _sp = 0; while (cond) { __builtin_amdgcn_s_sleep(1); \
    if ((++_sp & 255u) == 0u) { if (xb_ld(&(bar)[XB_TMO])) break; if (_sp > XB_SPIN_CAP) { atomicAdd(&(bar)[XB_TMO], 1u); break; } } } } while (0)

struct XcdBarrier {
    unsigned* bar; unsigned x; unsigned total;
    volatile LAS unsigned* st;
};

__device__ __forceinline__ XcdBarrier xcd_barrier_post(unsigned* bar, volatile LAS unsigned* st, unsigned total) {
    XcdBarrier b; b.bar = bar; b.x = xb_xcc_id(); b.st = st; b.total = total;
    if (threadIdx.x == 0) (void)xb_add(&bar[XB_XCNT(b.x)], 1u);
    return b;
}
__device__ __forceinline__ void xcd_barrier_complete(unsigned* bar, unsigned x, unsigned G, unsigned& nloc, unsigned& nx) {
    unsigned sum, cnt, mine, sp = 0u;
    for (;;) {
        sum = 0u; cnt = 0u; mine = 0u;
#pragma unroll
        for (unsigned j = 0; j < 16; ++j) { const unsigned c = xb_ld(&bar[XB_XCNT(j)]); sum += c; cnt += (c > 0u) ? 1u : 0u; mine = (j == x) ? c : mine; }
        if (sum == G) break;
        __builtin_amdgcn_s_sleep(1);
        if ((++sp & 255u) == 0u) { if (xb_ld(&bar[XB_TMO])) break; if (sp > XB_SPIN_CAP) { atomicAdd(&bar[XB_TMO], 1u); break; } }
    }
    nloc = mine > 0u ? mine : 1u; nx = cnt > 0u ? cnt : 1u;
}

__device__ __forceinline__ void xcd_barrier(const XcdBarrier& b) {
    asm volatile("s_waitcnt vmcnt(0)" ::: "memory");
    __syncthreads();
    if (threadIdx.x == 0) {
        unsigned* bar = b.bar;
        __builtin_amdgcn_s_waitcnt(0);
        unsigned nloc = b.st[0], nx = b.st[1];
        if (nloc == 0u) { xcd_barrier_complete(bar, b.x, b.total, nloc, nx); b.st[0] = nloc; b.st[1] = nx; }
        const unsigned old = xb_add(&bar[XB_XSUB(b.x)], 1u);
        const unsigned gen = old / nloc;
        if (old + 1u == (gen + 1u) * nloc) {
            __builtin_amdgcn_fence(__ATOMIC_RELEASE, "agent");
            asm volatile("s_waitcnt vmcnt(0)" ::: "memory");
            const unsigned og = xb_add(&bar[XB_TOP], 1u);
            const unsigned tg = og / nx;
            if (og + 1u == (tg + 1u) * nx) xb_add(&bar[XB_TOPGEN], 1u);
            else XB_SPIN(xb_ld(&bar[XB_TOPGEN]) == tg, bar);
            __builtin_amdgcn_fence(__ATOMIC_ACQUIRE, "agent");
            xb_add(&bar[XB_XGEN(b.x)], 1u);
            asm volatile("s_waitcnt vmcnt(0)" ::: "memory");
        } else {
            XB_SPIN(xb_ld(&bar[XB_XGEN(b.x)]) == gen, bar);
            __builtin_amdgcn_fence(__ATOMIC_ACQUIRE, "agent");
            asm volatile("s_waitcnt vmcnt(0)" ::: "memory");
        }
    }
    __syncthreads();
}

__device__ __forceinline__ void transpose_item(const float* W, int K, int N, bf16* WT, int k0, int n0, int drow0, LAS float* scr, int lane, const float* gain) {
#pragma unroll 8
    for (int i = 0; i < 32; ++i) { const int kk = 2 * i + (lane >> 5); const float gk = gain ? gain[k0 + kk] : 1.0f; scr[kk * 33 + (lane & 31)] = W[(size_t)(k0 + kk) * N + n0 + (lane & 31)] * gk; }
    LDS_WAIT(); asm volatile("" ::: "memory");
    const int c = lane & 7;
#pragma unroll
    for (int j = 0; j < 4; ++j) { const int n = (lane >> 3) + 8 * j; const LAS float* s = scr + (8 * c) * 33 + n;
        v4u o; o.x = pk2(s[0 * 33], s[1 * 33]); o.y = pk2(s[2 * 33], s[3 * 33]); o.z = pk2(s[4 * 33], s[5 * 33]); o.w = pk2(s[6 * 33], s[7 * 33]);
        *(v4u*)(WT + (size_t)(drow0 + n) * K + k0 + 8 * c) = o; }
    LDS_WAIT(); asm volatile("" ::: "memory");
}
__device__ __forceinline__ void weights_phase(const float* w_in, const float* w_out, const float* w_gate, const float* w_up, const float* w_down, const float* norm_mix, const float* norm_ffn,
                                              unsigned char* ws, LAS unsigned char* lds, int l0, int l1, int gw, int NGW, int wave, int lane) {
    LAS float* scr = (LAS float*)(lds + RING_OFF + wave * 16384);
    constexpr int I_IN = (D / 64) * (DIN / 32), I_OUT = (D / 64) * (D / 32), I_G = (D / 64) * (DFF / 32), I_DN = (DFF / 64) * (D / 32);
    constexpr int PER_LAYER = I_IN + I_OUT + 2 * I_G + I_DN;
    for (int it = l0 * PER_LAYER + gw; it < l1 * PER_LAYER; it += NGW) {
        const int l = it / PER_LAYER; int r = it % PER_LAYER;
        if (r < I_IN) { const int nb = r % (DIN / 32), kb = r / (DIN / 32);
            transpose_item(w_in + (size_t)l * D * DIN, D, DIN, (bf16*)(ws + WS_WIN + l * SZ_WIN), kb * 64, nb * 32, nb * 32, scr, lane, norm_mix + l * D); continue; } r -= I_IN;
        if (r < I_OUT) { const int nb = r % (D / 32), kb = r / (D / 32);
            transpose_item(w_out + (size_t)l * D * D, D, D, (bf16*)(ws + WS_WOUT + l * SZ_WOUT), kb * 64, nb * 32, nb * 32, scr, lane, nullptr); continue; } r -= I_OUT;
        if (r < I_G) { const int nb = r % (DFF / 32), kb = r / (DFF / 32), n0 = nb * 32;
            transpose_item(w_gate + (size_t)l * D * DFF, D, DFF, (bf16*)(ws + WS_WGU + l * SZ_WGU), kb * 64, n0, (n0 >> 7) * 256 + (n0 & 127), scr, lane, norm_ffn + l * D); continue; } r -= I_G;
        if (r < I_G) { const int nb = r % (DFF / 32), kb = r / (DFF / 32), n0 = nb * 32;
            transpose_item(w_up + (size_t)l * D * DFF, D, DFF, (bf16*)(ws + WS_WGU + l * SZ_WGU), kb * 64, n0, (n0 >> 7) * 256 + 128 + (n0 & 127), scr, lane, norm_ffn + l * D); continue; } r -= I_G;
        { const int nb = r % (D / 32), kb = r / (D / 32);
            transpose_item(w_down + (size_t)l * DFF * D, DFF, D, (bf16*)(ws + WS_WDN + l * SZ_WDN), kb * 64, nb * 32, nb * 32, scr, lane, nullptr); }
    }
}
__device__ __forceinline__ void xconv_phase(const float* x_in, bf16* xb, float* ss, const float* lb_logits, float* lbt, int gw, int NGW, int lane, int gtid) {
    for (int m = gw; m < M; m += NGW) {
        const f32x4* xr = (const f32x4*)(x_in + (size_t)m * D) + lane; v2u* o = (v2u*)(xb + (size_t)m * D) + lane; float s = 0.f;
#pragma unroll
        for (int j = 0; j < 8; ++j) { const f32x4 v = xr[64 * j]; v2u w; w.x = pk2(v.x, v.y); w.y = pk2(v.z, v.w); o[64 * j] = w;
            const float a = bf_lo(w.x), b = bf_hi(w.x), c = bf_lo(w.y), d = bf_hi(w.y); s += (a * a + b * b) + (c * c + d * d); }
        s = wave_sum(s);
        if (lane < 8) ss[(size_t)m * 8 + lane] = lane == 0 ? s : 0.f;
    }
    if (gtid < DH) {
        float lg[DEPTH], mx = -3.0e38f;
#pragma unroll
        for (int l = 0; l < DEPTH; ++l) { lg[l] = lb_logits[l * DH + gtid]; mx = fmaxf(mx, lg[l]); }
        float den = 0.f;
#pragma unroll
        for (int l = 0; l < DEPTH; ++l) { lg[l] = __expf(lg[l] - mx); den += lg[l]; }
        float cum = 0.f; const float p0 = lg[0] / den;
#pragma unroll
        for (int l = 0; l < DEPTH; ++l) { cum += lg[l] / den; lbt[l * DH + gtid] = fminf(fmaxf(cum - p0, 0.f), 1.0f - 1e-4f); }
    }
}
__device__ __forceinline__ void final_norm_phase(const bf16* x, const float* gain, float* out, int rows, int gw, int NGW, int lane) {
    f32x4 g[8];
#pragma unroll
    for (int j = 0; j < 8; ++j) g[j] = ((const f32x4*)gain)[lane + 64 * j];
    for (int m = gw; m < rows; m += NGW) {
        const v2u* xr = (const v2u*)(x + (size_t)m * D) + lane;
        f32x4 v[8]; float s = 0.f;
#pragma unroll
        for (int j = 0; j < 8; ++j) { const v2u w = xr[64 * j]; v[j] = (f32x4){bf_lo(w.x), bf_hi(w.x), bf_lo(w.y), bf_hi(w.y)}; s += (v[j].x * v[j].x + v[j].y * v[j].y) + (v[j].z * v[j].z + v[j].w * v[j].w); }
        const float rs = 1.0f / sqrtf(wave_sum(s) * (1.0f / D) + EPS);
        f32x4* o = (f32x4*)(out + (size_t)m * D) + lane;
#pragma unroll
        for (int j = 0; j < 8; ++j) o[64 * j] = v[j] * rs * g[j];
    }
}
__device__ __forceinline__ void conv_phase(const bf16* proj, const float* cw, const float* gn, bf16* mixed, int rows, int gw, int NGW, int lane) {
    constexpr int R = 16; const int NSTRIP = rows / R;
    float w0[2][8], w1[2][8], w2[2][8], gg[2][8];
#pragma unroll
    for (int i = 0; i < 2; ++i)
#pragma unroll
        for (int e = 0; e < 8; ++e) { const int c = i * 512 + lane * 8 + e; w0[i][e] = cw[c]; w1[i][e] = cw[DC + c]; w2[i][e] = cw[2 * DC + c]; gg[i][e] = gn[c]; }
    for (int strip = gw; strip < NSTRIP; strip += NGW) {
        const int m0 = strip * R, t0 = m0 % SEQ;
        float u1[2][8], u2[2][8];
#pragma unroll
        for (int i = 0; i < 2; ++i) {
            if (t0 == 0) {
#pragma unroll
                for (int e = 0; e < 8; ++e) { u1[i][e] = 0.f; u2[i][e] = 0.f; }
            } else {
                const bf16* p1 = proj + (size_t)(m0 - 1) * DIN + i * 512 + lane * 8; const bf16* p2 = p1 - DIN;
                float c1[8], h1[8], c2[8], h2[8];
                unpack8(*(const v4u*)(p1 + C_C), c1); unpack8(*(const v4u*)(p1 + C_H), h1); unpack8(*(const v4u*)(p2 + C_C), c2); unpack8(*(const v4u*)(p2 + C_H), h2);
#pragma unroll
                for (int e = 0; e < 8; ++e) { u1[i][e] = c1[e] * h1[e]; u2[i][e] = c2[e] * h2[e]; }
            }
        }
        for (int r = 0; r < R; ++r) {
            const size_t m = (size_t)(m0 + r);
#pragma unroll
            for (int i = 0; i < 2; ++i) {
                const bf16* p = proj + m * DIN + i * 512 + lane * 8;
                float bb[8], cc[8], hh[8], y[8]; unpack8(*(const v4u*)(p + C_B), bb); unpack8(*(const v4u*)(p + C_C), cc); unpack8(*(const v4u*)(p + C_H), hh);
                float ss = 0.f;
#pragma unroll
                for (int e = 0; e < 8; ++e) { const float u0 = cc[e] * hh[e]; y[e] = bb[e] * (w0[i][e] * u2[i][e] + w1[i][e] * u1[i][e] + w2[i][e] * u0); ss += y[e] * y[e]; u2[i][e] = u1[i][e]; u1[i][e] = u0; }
                const float rs = 1.0f / sqrtf(sum16(ss) * (1.0f / 128.0f) + EPS);
#pragma unroll
                for (int e = 0; e < 8; ++e) y[e] = y[e] * rs * gg[i][e];
                *(v4u*)(mixed + m * D + i * 512 + lane * 8) = pack8(y);
            }
        }
    }
}
__device__ __forceinline__ void hgrn_fin_phase(const bf16* proj, const float* gn, bf16* mixed, int gw, int NGW, int lane) {
    float gg[2][8];
#pragma unroll
    for (int i = 0; i < 2; ++i)
#pragma unroll
        for (int e = 0; e < 8; ++e) gg[i][e] = gn[i * 512 + lane * 8 + e];
    for (int m = gw; m < M; m += NGW) {
#pragma unroll
        for (int i = 0; i < 2; ++i) {
            bf16* po = mixed + (size_t)m * D + DC + i * 512 + lane * 8;
            float o[8], g[8]; unpack8(*(const v4u*)po, o); unpack8(*(const v4u*)(proj + (size_t)m * DIN + C_G + i * 512 + lane * 8), g);
            float ss = 0.f;
#pragma unroll
            for (int e = 0; e < 8; ++e) ss += o[e] * o[e];
            const float rs = 1.0f / sqrtf(sum16(ss) * (1.0f / 128.0f) + EPS);
#pragma unroll
            for (int e = 0; e < 8; ++e) o[e] = o[e] * rs * gg[i][e] * g[e];
            *(v4u*)po = pack8(o);
        }
    }
}

typedef short bf16x8_t __attribute__((ext_vector_type(8)));
typedef short s16x4_t __attribute__((ext_vector_type(4)));
typedef short v4i16_t __attribute__((ext_vector_type(4)));
typedef float f32x16 __attribute__((ext_vector_type(16)));
typedef float f32x2_t __attribute__((ext_vector_type(2)));
typedef __bf16 bf16x2_t __attribute__((ext_vector_type(2)));
__device__ __forceinline__ unsigned cvtpk(float lo, float hi) { f32x2_t v = {lo, hi}; bf16x2_t b = __builtin_convertvector(v, bf16x2_t); return __builtin_bit_cast(unsigned, b); }
__device__ __forceinline__ s16x4_t tr_read(const LAS unsigned char* p) { return __builtin_bit_cast(s16x4_t, __builtin_amdgcn_ds_read_tr16_b64_v4i16((LAS v4i16_t*)p)); }
__device__ __forceinline__ constexpr int crow_c(int i, int h) { return (i & 3) + 8 * (i >> 2) + 4 * h; }
#define HG_BAR() do { asm volatile("s_waitcnt lgkmcnt(0)" ::: "memory"); __builtin_amdgcn_s_barrier(); asm volatile("" ::: "memory"); } while (0)
#define MFMA32(a, b, c) __builtin_amdgcn_mfma_f32_32x32x16_bf16((a), (b), (c), 0, 0, 0)
constexpr int HG_RS = 272, HG_TS = 144, HG_VS = 320;
constexpr int HG_QD = 0, HG_Q1 = HG_QD + 64 * HG_RS, HG_K0 = HG_Q1 + 32 * HG_RS, HG_K1 = HG_K0 + 32 * HG_RS, HG_K1T = HG_K1 + 64 * HG_RS, HG_VN = HG_K1T + 128 * HG_TS,
              HG_SBT = HG_VN + 64 * HG_VS, HG_NRM = HG_SBT + 128 * HG_RS, HG_TOT = HG_NRM + 64 * 4 * 4, HG_END = HG_TOT + 8 * 128 * 4;
constexpr int HG_D1 = RING_BYTES + 9472, HG_D2 = HG_D1 + 512;
static_assert(HG_END <= RING_BYTES && HG_D2 + 512 <= LDS_BYTES && (HG_Q1 % 16) == 0 && (HG_K1T % 16) == 0 && (HG_VN % 16) == 0 && (HG_SBT % 16) == 0 && (HG_NRM % 16) == 0 && (HG_TOT % 16) == 0, "HGRN LDS map");
__device__ __forceinline__ bf16x8_t pack_step(const f32x16& x, int s) {
    v4u p; p.x = cvtpk(x[8 * s], x[8 * s + 1]); p.y = cvtpk(x[8 * s + 2], x[8 * s + 3]); p.z = cvtpk(x[8 * s + 4], x[8 * s + 5]); p.w = cvtpk(x[8 * s + 6], x[8 * s + 7]);
    return __builtin_bit_cast(bf16x8_t, p);
}
__device__ __forceinline__ void hgrn_chunk_phase(const bf16* proj, const float* gn, bf16* mixed, int nitems, int item0, int istride, LAS unsigned char* lds, int tid, int wave, int lane) {
    const int r = lane & 31, h = lane >> 5;
    const int tt = wave >> 2, vt = wave & 3;
    const int kt = wave >> 1, vs = 2 * (wave & 1);
    for (int item = item0; item < nitems; item += istride) {
        const int b = item >> 3, hd = item & 7;
        f32x16 S0, S1;
#pragma unroll
        for (int i = 0; i < 16; ++i) { S0[i] = 0.f; S1[i] = 0.f; }
        float gnv[4][4];
#pragma unroll
        for (int g = 0; g < 4; ++g)
#pragma unroll
            for (int j = 0; j < 4; ++j) gnv[g][j] = gn[hd * HD + vt * 32 + 8 * g + 4 * h + j];
        const bf16* pz = proj + (size_t)(b * SEQ + 8 * wave) * DIN + C_Z + hd * HD + 2 * lane;
        const bf16* pq = proj + (size_t)(b * SEQ + 8 * wave) * DIN + C_Q + hd * HD + 2 * lane;
        const bf16* pv = proj + (size_t)(b * SEQ + 8 * wave) * DIN + C_I + hd * HD + 2 * lane;
        const bf16* pg = proj + (size_t)(b * SEQ + tt * 32 + r) * DIN + C_G + hd * HD + vt * 32 + 4 * h;
        unsigned rz[8], rq[8], rv[8];
#pragma unroll
        for (int i = 0; i < 8; ++i) { rz[i] = *(const unsigned*)(pz + (size_t)i * DIN); rq[i] = *(const unsigned*)(pq + (size_t)i * DIN); rv[i] = *(const unsigned*)(pv + (size_t)i * DIN); }
        for (int c = 0; c < SEQ / 64; ++c) {
            float bl[8][2], kk[8][2], qs[8][2];
#pragma unroll
            for (int i = 0; i < 8; ++i) {
#pragma unroll
                for (int e = 0; e < 2; ++e) {
                    const float l2 = e ? bf_hi(rz[i]) : bf_lo(rz[i]);
                    qs[i][e] = e ? bf_hi(rq[i]) : bf_lo(rq[i]);
                    kk[i][e] = 1.0f - __builtin_amdgcn_exp2f(l2);
                    bl[i][e] = (i == 0) ? l2 : bl[i - 1][e] + l2;
                }
            }
            const size_t onext = (size_t)(c + 1 < SEQ / 64 ? c + 1 : c) * 64 * DIN;
#pragma unroll
            for (int i = 0; i < 8; ++i) { rz[i] = *(const unsigned*)(pz + onext + (size_t)i * DIN); rq[i] = *(const unsigned*)(pq + onext + (size_t)i * DIN); }
            *(LAS f32x2_t*)(lds + HG_TOT + (wave * 128 + 2 * lane) * 4) = (f32x2_t){bl[7][0], bl[7][1]};
            HG_BAR();
            float off[2] = {0.f, 0.f}, b31[2] = {0.f, 0.f}, b63[2] = {0.f, 0.f};
#pragma unroll
            for (int w = 0; w < 8; ++w) { const f32x2_t tw = *(const LAS f32x2_t*)(lds + HG_TOT + (w * 128 + 2 * lane) * 4);
                if (w < wave) { off[0] += tw.x; off[1] += tw.y; } if (w < 4) { b31[0] += tw.x; b31[1] += tw.y; } b63[0] += tw.x; b63[1] += tw.y; }
            const bool up = wave >= 4;
            unsigned k1t[2][4];
#pragma unroll
            for (int i = 0; i < 8; ++i) {
                const int t = 8 * wave + i;
                float qd[2], x2[2], k1[2];
#pragma unroll
                for (int e = 0; e < 2; ++e) { const float bt = off[e] + bl[i][e];
                    qd[e] = qs[i][e] * __builtin_amdgcn_exp2f(bt);
                    x2[e] = (up ? qs[i][e] : kk[i][e]) * __builtin_amdgcn_exp2f(up ? bt - b31[e] : fminf(-bt, 115.0f));
                    k1[e] = kk[i][e] * __builtin_amdgcn_exp2f(fminf(b31[e] - bt, 115.0f)); }
                *(LAS unsigned*)(lds + HG_QD + t * HG_RS + 4 * lane) = cvtpk(qd[0], qd[1]);
                *(LAS unsigned*)(lds + (up ? HG_Q1 + (t - 32) * HG_RS : HG_K0 + t * HG_RS) + 4 * lane) = cvtpk(x2[0], x2[1]);
                const unsigned kp = cvtpk(k1[0], k1[1]);
                *(LAS unsigned*)(lds + HG_K1 + t * HG_RS + 4 * lane) = kp;
                if ((i & 1) == 0) { k1t[0][i >> 1] = kp & 0xffffu; k1t[1][i >> 1] = kp >> 16; }
                else { k1t[0][i >> 1] |= kp << 16; k1t[1][i >> 1] |= kp & 0xffff0000u; }
            }
            *(LAS v4u*)(lds + HG_K1T + (2 * lane) * HG_TS + 16 * wave) = (v4u){k1t[0][0], k1t[0][1], k1t[0][2], k1t[0][3]};
            *(LAS v4u*)(lds + HG_K1T + (2 * lane + 1) * HG_TS + 16 * wave) = (v4u){k1t[1][0], k1t[1][1], k1t[1][2], k1t[1][3]};
            if (wave == 0) { *(LAS f32x2_t*)(lds + HG_D1 + 8 * lane) = (f32x2_t){__builtin_amdgcn_exp2f(b31[0]), __builtin_amdgcn_exp2f(b31[1])};
                             *(LAS f32x2_t*)(lds + HG_D2 + 8 * lane) = (f32x2_t){__builtin_amdgcn_exp2f(b63[0] - b31[0]), __builtin_amdgcn_exp2f(b63[1] - b31[1])}; }
#pragma unroll
            for (int i = 0; i < 8; ++i) *(LAS unsigned*)(lds + HG_VN + (8 * wave + i) * HG_VS + 4 * lane) = rv[i];
#pragma unroll
            for (int i = 0; i < 8; ++i) rv[i] = *(const unsigned*)(pv + onext + (size_t)i * DIN);
            {
#pragma unroll
                for (int g = 0; g < 4; ++g) {
                    *(LAS v2u*)(lds + HG_SBT + (vs * 32 + r) * HG_RS + (kt * 32 + 8 * g + 4 * h) * 2) = (v2u){cvtpk(S0[4 * g], S0[4 * g + 1]), cvtpk(S0[4 * g + 2], S0[4 * g + 3])};
                    *(LAS v2u*)(lds + HG_SBT + (vs * 32 + 32 + r) * HG_RS + (kt * 32 + 8 * g + 4 * h) * 2) = (v2u){cvtpk(S1[4 * g], S1[4 * g + 1]), cvtpk(S1[4 * g + 2], S1[4 * g + 3])};
                }
            }
            v2u rg[4];
#pragma unroll
            for (int g = 0; g < 4; ++g) rg[g] = *(const v2u*)(pg + (size_t)c * 64 * DIN + 8 * g);
            HG_BAR();
            f32x16 acc;
            {
                f32x16 X0, X1;
#pragma unroll
                for (int i = 0; i < 16; ++i) { X0[i] = 0.f; X1[i] = 0.f; acc[i] = 0.f; }
                const LAS unsigned char* pa_s = lds + HG_SBT + (vt * 32 + r) * HG_RS + 16 * h;
                const LAS unsigned char* pb_q = lds + HG_QD + (tt * 32 + r) * HG_RS + 16 * h;
                if (tt == 0) {
                    const LAS unsigned char* pa_k = lds + HG_K0 + r * HG_RS + 16 * h;
#pragma unroll
                    for (int ks = 0; ks < 8; ++ks) { const bf16x8_t bq = *(const LAS bf16x8_t*)(pb_q + 32 * ks);
                        X0 = MFMA32(*(const LAS bf16x8_t*)(pa_k + 32 * ks), bq, X0);
                        acc = MFMA32(*(const LAS bf16x8_t*)(pa_s + 32 * ks), bq, acc); }
#pragma unroll
                    for (int i = 0; i < 16; ++i) if (crow_c(i, h) > r) X0[i] = 0.f;
                } else {
                    const LAS unsigned char* pb_1 = lds + HG_Q1 + r * HG_RS + 16 * h;
                    const LAS unsigned char* pa_k = lds + HG_K1 + r * HG_RS + 16 * h;
#pragma unroll
                    for (int ks = 0; ks < 8; ++ks) { const bf16x8_t b1 = *(const LAS bf16x8_t*)(pb_1 + 32 * ks);
                        X0 = MFMA32(*(const LAS bf16x8_t*)(pa_k + 32 * ks), b1, X0);
                        X1 = MFMA32(*(const LAS bf16x8_t*)(pa_k + 32 * HG_RS + 32 * ks), b1, X1);
                        acc = MFMA32(*(const LAS bf16x8_t*)(pa_s + 32 * ks), *(const LAS bf16x8_t*)(pb_q + 32 * ks), acc); }
#pragma unroll
                    for (int i = 0; i < 16; ++i) if (crow_c(i, h) > r) X1[i] = 0.f;
                }
                const LAS unsigned char* pvt = lds + HG_VN + (4 * h + ((lane & 15) >> 2)) * HG_VS + (vt * 32 + ((lane >> 4) & 1) * 16 + (lane & 3) * 4) * 2;
#pragma unroll
                for (int s2 = 0; s2 < 2; ++s2) {
                    const s16x4_t lo = tr_read(pvt + (16 * s2) * HG_VS), hi = tr_read(pvt + (16 * s2 + 8) * HG_VS);
                    acc = MFMA32(__builtin_shufflevector(lo, hi, 0, 1, 2, 3, 4, 5, 6, 7), pack_step(X0, s2), acc);
                }
                if (tt == 1) {
#pragma unroll
                    for (int s2 = 0; s2 < 2; ++s2) {
                        const s16x4_t lo = tr_read(pvt + (32 + 16 * s2) * HG_VS), hi = tr_read(pvt + (32 + 16 * s2 + 8) * HG_VS);
                        acc = MFMA32(__builtin_shufflevector(lo, hi, 0, 1, 2, 3, 4, 5, 6, 7), pack_step(X1, s2), acc);
                    }
                }
            }
            {
                float ssq = 0.f;
#pragma unroll
                for (int i = 0; i < 16; ++i) ssq += acc[i] * acc[i];
                ssq += __shfl_xor(ssq, 32);
                if (h == 0) *(LAS float*)(lds + HG_NRM + ((tt * 32 + r) * 4 + vt) * 4) = ssq;
            }
            {
                f32x4 d1[4], d2[4];
#pragma unroll
                for (int g = 0; g < 4; ++g) { d1[g] = *(const LAS f32x4*)(lds + HG_D1 + (kt * 32 + 8 * g + 4 * h) * 4); d2[g] = *(const LAS f32x4*)(lds + HG_D2 + (kt * 32 + 8 * g + 4 * h) * 4); }
#pragma unroll
                for (int i = 0; i < 16; ++i) { S0[i] *= d1[i >> 2][i & 3]; S1[i] *= d1[i >> 2][i & 3]; }
                const LAS unsigned char* pa = lds + HG_K1T + (kt * 32 + r) * HG_TS + 16 * h;
                const LAS unsigned char* pvn = lds + HG_VN + (8 * h + ((lane & 15) >> 2)) * HG_VS + (vs * 32 + ((lane >> 4) & 1) * 16 + (lane & 3) * 4) * 2;
#pragma unroll
                for (int ks = 0; ks < 4; ++ks) {
                    const bf16x8_t a = *(const LAS bf16x8_t*)(pa + 32 * ks);
                    const s16x4_t l0 = tr_read(pvn + (16 * ks) * HG_VS), h0 = tr_read(pvn + (16 * ks + 4) * HG_VS);
                    const s16x4_t l1 = tr_read(pvn + (16 * ks) * HG_VS + 64), h1 = tr_read(pvn + (16 * ks + 4) * HG_VS + 64);
                    S0 = MFMA32(a, __builtin_shufflevector(l0, h0, 0, 1, 2, 3, 4, 5, 6, 7), S0);
                    S1 = MFMA32(a, __builtin_shufflevector(l1, h1, 0, 1, 2, 3, 4, 5, 6, 7), S1);
                }
#pragma unroll
                for (int i = 0; i < 16; ++i) { S0[i] *= d2[i >> 2][i & 3]; S1[i] *= d2[i >> 2][i & 3]; }
            }
            HG_BAR();
            {
                const f32x4 pn = *(const LAS f32x4*)(lds + HG_NRM + (tt * 32 + r) * 16);
                const float rs = 1.0f / sqrtf(((pn[0] + pn[1]) + (pn[2] + pn[3])) * (1.0f / 128.0f) + EPS);
                bf16* po = mixed + (size_t)(b * SEQ + c * 64 + tt * 32 + r) * D + DC + hd * HD + vt * 32 + 4 * h;
#pragma unroll
                for (int g = 0; g < 4; ++g) { const float g0 = bf_lo(rg[g].x), g1 = bf_hi(rg[g].x), g2 = bf_lo(rg[g].y), g3 = bf_hi(rg[g].y);
                    *(v2u*)(po + 8 * g) = (v2u){cvtpk(acc[4 * g] * rs * gnv[g][0] * g0, acc[4 * g + 1] * rs * gnv[g][1] * g1), cvtpk(acc[4 * g + 2] * rs * gnv[g][2] * g2, acc[4 * g + 3] * rs * gnv[g][3] * g3)}; }
            }
        }
    }
}

#ifndef DUP_GOUT
#define DUP_GOUT 0
#endif
#ifndef DUP_NORM
#define DUP_NORM 0
#endif
#ifndef DUP_GIN
#define DUP_GIN 0
#endif
#ifndef DUP_REC
#define DUP_REC 0
#endif
#ifndef DUP_CONV
#define DUP_CONV 0
#endif
#ifndef DUP_GGU
#define DUP_GGU 0
#endif
#ifndef DUP_PRO
#define DUP_PRO 0
#endif
__device__ __forceinline__ void stagger(int bx, int ng, int dticks) {
    const int g = (bx >> 3) % ng; if (g == 0 || dticks == 0) return;
    const unsigned long long t0 = __builtin_amdgcn_s_memrealtime(), dt = (unsigned long long)(g * dticks);
    while (__builtin_amdgcn_s_memrealtime() - t0 < dt) __builtin_amdgcn_s_sleep(8);
}
#ifndef STG_NG
#define STG_NG 4
#endif
#ifndef STG_IN
#define STG_IN 0
#endif
#ifndef STG_OUT
#define STG_OUT 0
#endif
#ifndef STG_GU
#define STG_GU 0
#endif
#ifndef STG_DN
#define STG_DN 0
#endif
struct FixedOrder { int n;
    __device__ bool next(int i, pg8::Unit& u) const { if (i >= n) return false; u.pm = 0; u.pn = 0; return true; }
    __device__ __forceinline__ void a_ready(const pg8::Unit&) const {}
    __device__ __forceinline__ void done(const pg8::Unit&) const {} };
#ifndef PROBE_HALF
#define PROBE_HALF 0
#endif
#ifndef PROBE_FIXED
#define PROBE_FIXED 0
#endif
#ifndef TPROBE
#define TPROBE 0
#endif
#ifndef TP_BLOCK
#define TP_BLOCK 0
#endif
#ifndef TP_MAG
#define TP_MAG 4
#endif
#define TP_B(k) do { if (TPROBE == (k)) tp_t0 = __builtin_amdgcn_s_memrealtime(); } while (0)
#define TP_E(k) do { if (TPROBE == (k)) tp_acc += __builtin_amdgcn_s_memrealtime() - tp_t0; } while (0)
constexpr int CW_BAR0 = 4096, CW_BARG = CW_BAR0 + XCD_BAR_WORDS;
struct Args { const float* in[13]; float* out; unsigned char* ws; int ph_lo, ph_hi; };
__global__ void __launch_bounds__(NTHR, 2) fwd(Args args) {
    extern __shared__ __attribute__((aligned(16))) unsigned char lds_raw[];
    LAS unsigned char* lds = (LAS unsigned char*)lds_raw;
    volatile LAS unsigned* MISC = (volatile LAS unsigned*)(lds + MISC_OFF);
    const int tid = threadIdx.x, lane = tid & 63, wave = __builtin_amdgcn_readfirstlane(tid >> 6);
    const int G = gridDim.x, bx = blockIdx.x, vcu = (G % 8 == 0) ? (bx % 8) * (G / 8) + bx / 8 : bx;
    const int gw = vcu * NWAVES + wave, NGW = G * NWAVES, gtid = vcu * NTHR + tid;
    unsigned char* ws = args.ws;
    unsigned* ctl = (unsigned*)(ws + WS_CTL);
    if (tid < 32) MISC[tid] = 0u;
    __syncthreads();
    const int label = bx & 7, jg = bx >> 3, GL = G >> 3;
    XcdBarrier bar0 = xcd_barrier_post(ctl + CW_BAR0, MISC + 8, (unsigned)G);
    XcdBarrier bar = xcd_barrier_post(ctl + CW_BARG + label * XCD_BAR_WORDS, MISC + 10, (unsigned)GL);
#define GRID_BAR() do { TP_B(1); xcd_barrier(bar); TP_E(1); } while (0)
    const float* x_in = args.in[0]; const float* norm_mix = args.in[1]; const float* w_in = args.in[2]; const float* conv_w = args.in[3]; const float* gn_conv = args.in[4];
    const float* lb_logits = args.in[5]; const float* gn_hgrn = args.in[6]; const float* w_out = args.in[7]; const float* norm_ffn = args.in[8];
    const float* w_gate = args.in[9]; const float* w_up = args.in[10]; const float* w_down = args.in[11]; const float* norm_final = args.in[12];
    float* out = args.out;
    bf16* HB = (bf16*)(ws + WS_HB); bf16* PROJ = (bf16*)(ws + WS_PROJ);
    const float* LBT = (const float*)(ws + WS_LB);
    const int lo = args.ph_lo, hi = args.ph_hi;
    unsigned long long tp_t0 = 0, tp_acc = 0; (void)tp_t0; (void)tp_acc;
#define IN(k) (lo <= (k) && (k) < hi)
#define SEAM(k) do { if (IN((k) + 1)) GRID_BAR(); } while (0)

    bf16* XB = (bf16*)((unsigned char*)out + (size_t)M * D * 2);
    float* SS = (float*)(ws + WS_SS);
    LAS float* PSS = (LAS float*)(lds + PSS_OFF); LAS float* RST = (LAS float*)(lds + RST_OFF);
    if (IN(0)) { TP_B(10);
        weights_phase(w_in, w_out, w_gate, w_up, w_down, norm_mix, norm_ffn, ws, lds, 0, DEPTH, gw, NGW, wave, lane);
        xconv_phase(x_in, XB, SS, lb_logits, (float*)(ws + WS_LB), gw, NGW, lane, gtid);
        TP_E(10); TP_B(1); xcd_barrier(bar0); TP_E(1); }
    for (int l = 0; l < DEPTH; ++l) {
        const int p = 1 + 5 * l;
        int tq = threadIdx.x; asm volatile("" : "+v"(tq));
        const int tid = tq, lane = tq & 63;
        if (IN(p + 0)) {
            TP_B(4);
            pg8::Gemm g{XB, (const bf16*)(ws + WS_WIN + l * SZ_WIN), M, DIN, D, D}; pg8::StaticOrder S; S.init(M, DIN, G, bx); pg8::EpiProj E{PROJ, DIN, LBT + l * DH, SS, RST};
            if (tid == 0) RST[0] = 0.f; __syncthreads();
            pg8::gemm_phase<pg8::EpiProj, pg8::StaticOrder, true, PG8_SP2V>(lds + RING_OFF, g, S, E, tp_acc);
#if PROBE_FIXED
            {
                const bool active = PROBE_HALF == 0 ? true : (PROBE_HALF == 1 ? (bx & 7) < 4 : ((bx >> 3) & 1) == 0);
                if (active) { pg8::StaticOrder S2; S2.init(M, DIN, G, bx); S2.fixed = 14; pg8::EpiProj E2{(bf16*)(ws + WS_END) + (size_t)bx * 65536, 256, LBT + l * DH, SS, RST};
                    pg8::gemm_phase<pg8::EpiProj, pg8::StaticOrder, true, PG8_SP2V>(lds + RING_OFF, g, S2, E2, tp_acc); } }
#endif
            TP_E(4); SEAM(p + 0); }
        if (IN(p + 1)) {
            const int i16 = jg >> 1;
            if ((jg & 1) == 0) { TP_B(7); const int item = (2 * label + (i16 >> 3)) * HEADS + (i16 & 7); hgrn_chunk_phase(PROJ, gn_hgrn + l * DH, HB, item + 1, item, 1, lds + RING_OFF, tid, wave, lane); TP_E(7); }
            else { TP_B(8); const size_t rb = (size_t)label * 2 * SEQ;
                conv_phase(PROJ + rb * DIN, conv_w + l * 3 * DC, gn_conv + l * DC, HB + rb * D, 2 * SEQ, i16 * NWAVES + wave, (GL >> 1) * NWAVES, lane); TP_E(8); }
            SEAM(p + 1); }
        if (IN(p + 2)) {
            TP_B(3);
            pg8::Gemm g{HB, (const bf16*)(ws + WS_WOUT + l * SZ_WOUT), M, D, D, D}; pg8::StaticOrder S; S.init(M, D, G, bx); pg8::EpiResBf16 E{XB, XB, D, SS, PSS};
            pg8::gemm_phase<pg8::EpiResBf16, pg8::StaticOrder, true, PG8_SP2V>(lds + RING_OFF, g, S, E, tp_acc);
            TP_E(3); SEAM(p + 2); }
        if (IN(p + 3)) {
            TP_B(5);
            pg8::Gemm g{XB, (const bf16*)(ws + WS_WGU + l * SZ_WGU), M, NGU, D, D}; pg8::StaticOrder S; S.init(M, NGU, G, bx); pg8::EpiSwiGLU E{PROJ, DIN, SS, RST};
            if (tid == 0) RST[0] = 0.f; __syncthreads();
            pg8::gemm_phase<pg8::EpiSwiGLU, pg8::StaticOrder, true, PG8_SP2V>(lds + RING_OFF, g, S, E, tp_acc);
            TP_E(5); SEAM(p + 3); }
        if (IN(p + 4)) {
            TP_B(2);
            pg8::Gemm g{PROJ, (const bf16*)(ws + WS_WDN + l * SZ_WDN), M, D, DFF, DIN};     pg8::StaticOrder S; S.init(M, D, G, bx); pg8::EpiResBf16 E{XB, l == DEPTH - 1 ? HB : XB, D, SS, PSS};
            pg8::gemm_phase<pg8::EpiResBf16, pg8::StaticOrder, true, PG8_SP2V>(lds + RING_OFF, g, S, E, tp_acc);
            TP_E(2); SEAM(p + 4); }
    }
    TP_B(1); xcd_barrier(bar0); TP_E(1);
    if (IN(NPH - 1)) { TP_B(11); const size_t rb = (size_t)label * 2 * SEQ; final_norm_phase(HB + rb * D, norm_final, out + rb * D, 2 * SEQ, jg * NWAVES + wave, GL * NWAVES, lane); TP_E(11); }
#if TPROBE
    if (bx == TP_BLOCK && tid == 0) { const unsigned long long t0 = __builtin_amdgcn_s_memrealtime(), dt = tp_acc * TP_MAG; while (__builtin_amdgcn_s_memrealtime() - t0 < dt) __builtin_amdgcn_s_sleep(16); }
#endif
#undef IN
#undef SEAM
}

extern "C" void kernel_launch(void* const* d_in, const int* in_sizes, int n_in, void* d_out, int out_size, void* d_ws, size_t ws_size, hipStream_t stream) {
    static int grid = 0;
    if (grid == 0) {
        if (n_in != 13 || in_sizes[0] != M * D || out_size != M * D || ws_size < WS_END) { fprintf(stderr, "kernel_launch: unexpected shapes (n_in %d, in0 %d, out %d, ws %zu < %zu); nothing launched\n", n_in, n_in > 0 ? in_sizes[0] : -1, out_size, ws_size, (size_t)WS_END); grid = -1; return; }
        int dev = 0, cus = 0;
        if (hipGetDevice(&dev) != hipSuccess || hipDeviceGetAttribute(&cus, hipDeviceAttributeMultiprocessorCount, dev) != hipSuccess) { grid = -1; return; }
        if (hipFuncSetAttribute((const void*)fwd, hipFuncAttributeMaxDynamicSharedMemorySize, LDS_BYTES) != hipSuccess) { fprintf(stderr, "kernel_launch: hipFuncSetAttribute failed\n"); grid = -1; return; }
        (void)hipGetLastError();
        grid = cus;
    }
    if (grid < 0) return;
    (void)hipMemsetAsync((char*)d_ws + WS_CTL, 0, CTL_ZERO_BYTES, stream);
    Args a{};
    for (int i = 0; i < 13; ++i) a.in[i] = (const float*)d_in[i];
    a.out = (float*)d_out; a.ws = (unsigned char*)d_ws;
#if MK_ONE_LAUNCH
    a.ph_lo = 0; a.ph_hi = NPH;
    hipLaunchKernelGGL(fwd, dim3(grid), dim3(NTHR), LDS_BYTES, stream, a);
#else
    for (int p = 0; p < NPH; ++p) { a.ph_lo = p; a.ph_hi = p + 1; hipLaunchKernelGGL(fwd, dim3(grid), dim3(NTHR), LDS_BYTES, stream, a); }
#endif
}
```

```cpp
#include <hip/hip_runtime.h>
#include <cstdio>
#include <cstdint>
#define MK_ONE_LAUNCH 1
#define PG8_WGM 4
#ifndef RELAX_EPI
#define RELAX_EPI 1
#endif
#ifndef PG8_WGM
#define PG8_WGM 8
#endif
#ifndef PG8_SP2V
#define PG8_SP2V true
#endif
#ifndef PG8_ALIGNV
#define PG8_ALIGNV true
#endif
#ifndef TPROBE
#define TPROBE 0
#endif
namespace pg8 {
#define PG8_LAS __attribute__((address_space(3)))
typedef unsigned short bf16_t;
typedef short bf16x8 __attribute__((ext_vector_type(8)));
typedef float f32x4 __attribute__((ext_vector_type(4)));
typedef unsigned u32x4 __attribute__((ext_vector_type(4)));
constexpr int BM = 256, BK = 64, HALF = 128, HTB = HALF * BK * 2  , STAGE_BYTES = 8 * HTB, NXCD = 8, WGM = PG8_WGM;

__host__ __device__ __forceinline__ int lds_byte(int r, int c) { const int st = (r >> 4) * 2 + (c >> 5), rr = r & 15, cc = c & 31, ob = rr * 64 + cc * 2; return st * 1024 + (ob ^ (((ob >> 9) & 1) << 5)); }
__host__ __device__ __forceinline__ void stage_rc(int b, int& R, int& C) { const int st = b / 1024, sb = b % 1024, swz = sb ^ (((sb >> 9) & 1) << 5); R = (st >> 1) * 16 + swz / 64; C = (st & 1) * 32 + (swz % 64) / 2; }
__host__ __device__ __forceinline__ int perm32(int rho) { const int n = rho >> 4, i = rho & 15; return 8 * (i >> 2) + 4 * n + (i & 3); }

struct Unit { int pm, pn; };
struct Gemm { const bf16_t* A; const bf16_t* Bt; int M, N, K; };

struct StaticOrder {
    int nM, nN, nwg, G, c; int fixed = 0;
    __host__ __device__ void init(int M, int N, int G_, int c_) { nM = M / BM; nN = N / BM; nwg = nM * nN; G = G_; c = c_; }
    __host__ __device__ bool next(int i, Unit& u) const {
        if (fixed) { if (i >= fixed) return false; u.pm = 0; u.pn = 0; return true; }
        const long L = (long)i * G + c; if (L >= nwg) return false;
        int wgid = (int)L; { const int q = nwg / NXCD, r = nwg % NXCD, xcd = wgid % NXCD, off = wgid / NXCD; wgid = (xcd < r ? xcd * (q + 1) : r * (q + 1) + (xcd - r) * q) + off; }
        const int nig = WGM * nN, gid = wgid / nig, fm = gid * WGM, gsz = (nM - fm) < WGM ? (nM - fm) : WGM;
        u.pm = fm + ((wgid % nig) % gsz); u.pn = (wgid % nig) / gsz; return true;
    }
    __device__ __forceinline__ void a_ready(const Unit&) const {}
    __device__ __forceinline__ void done(const Unit&) const {}
};

__device__ __forceinline__ unsigned cvt_pk_bf16(float lo, float hi) { unsigned r; asm volatile("v_cvt_pk_bf16_f32 %0, %1, %2" : "=v"(r) : "v"(lo), "v"(hi)); return r; }
typedef float f32x2 __attribute__((ext_vector_type(2)));
#if defined(NT_STORES) && NT_STORES
#define ST16(p, v) __builtin_nontemporal_store((v), (u32x4*)(p))
#else
#define ST16(p, v) (*(u32x4*)(p) = (v))
#endif
__device__ __forceinline__ float silu_f(float x) { return x * __builtin_amdgcn_rcpf(1.0f + __builtin_amdgcn_exp2f(-1.44269504089f * x)); }
__device__ __forceinline__ void row_scale_table(const float* ss, PG8_LAS float* RS, int pm, int t) {
    const int tag = __builtin_amdgcn_readfirstlane(__float_as_int(RS[0]));
    if (tag != pm + 1) {
        asm volatile("s_waitcnt lgkmcnt(0)" ::: "memory"); __builtin_amdgcn_s_barrier(); asm volatile("" ::: "memory");
        if (t < BM) { const f32x4* p = (const f32x4*)(ss + (size_t)(pm * BM + t) * 8); const f32x4 a = p[0], b = p[1];
            RS[4 + t] = 1.0f / __builtin_sqrtf((((a[0] + a[1]) + (a[2] + a[3])) + ((b[0] + b[1]) + (b[2] + b[3]))) * (1.0f / 2048.0f) + 1e-6f);
            if (t == 0) RS[0] = __int_as_float(pm + 1); }
        asm volatile("s_waitcnt lgkmcnt(0)" ::: "memory"); __builtin_amdgcn_s_barrier(); asm volatile("" ::: "memory");
    }
}
struct EpiBf16Plain {
    static constexpr bool PERM = true, AFTER_DRAIN = false; static constexpr int NST = 16;
    bf16_t* O; int ldc;
    __device__ __forceinline__ void operator()(const f32x4 (&acc)[2][2][4][2], const Unit& u, int wr, int wc, int fr, int fq) const {
        const int row0 = u.pm * BM + wr * 64 + fr, col0 = u.pn * BM + wc * 32 + 8 * fq;
#pragma unroll
        for (int ai = 0; ai < 2; ++ai)
#pragma unroll
            for (int m = 0; m < 4; ++m) { bf16_t* rowp = O + (size_t)(row0 + ai * HALF + m * 16) * ldc + col0;
#pragma unroll
                for (int bj = 0; bj < 2; ++bj) { const f32x4 v0 = acc[ai][bj][m][0], v1 = acc[ai][bj][m][1];
                    u32x4 w; w.x = cvt_pk_bf16(v0[0], v0[1]); w.y = cvt_pk_bf16(v0[2], v0[3]); w.z = cvt_pk_bf16(v1[0], v1[1]); w.w = cvt_pk_bf16(v1[2], v1[3]);
                    *(u32x4*)(rowp + bj * HALF) = w; } }
    }
};
struct EpiProj {
    static constexpr bool PERM = true, AFTER_DRAIN = false; static constexpr int NST = 16;
    bf16_t* O; int ldc; const float* lbt; const float* ss; PG8_LAS float* RS;
    __device__ __forceinline__ void operator()(const f32x4 (&acc)[2][2][4][2], const Unit& u, int wr, int wc, int fr, int fq) const {
        const int row0 = u.pm * BM + wr * 64 + fr, col0 = u.pn * BM + wc * 32 + 8 * fq, kind = u.pn >> 2;
        row_scale_table(ss, RS, u.pm, (wr * 4 + wc) * 64 + fq * 16 + fr);
        f32x4 lbv[2][2];
        if (kind == 4) {
#pragma unroll
            for (int bj = 0; bj < 2; ++bj)
#pragma unroll
                for (int n = 0; n < 2; ++n) lbv[bj][n] = *(const f32x4*)(lbt + (col0 - 4096) + bj * HALF + 4 * n);
        }
#pragma unroll
        for (int ai = 0; ai < 2; ++ai) { float rs[4];
#pragma unroll
            for (int m = 0; m < 4; ++m) rs[m] = RS[4 + ai * HALF + wr * 64 + m * 16 + fr];
#pragma unroll
            for (int m = 0; m < 4; ++m) { bf16_t* rowp = O + (size_t)(row0 + ai * HALF + m * 16) * ldc + col0;
#pragma unroll
                for (int bj = 0; bj < 2; ++bj) { f32x4 v[2] = {acc[ai][bj][m][0] * rs[m], acc[ai][bj][m][1] * rs[m]};
                    if (kind == 3 || kind == 6) {
#pragma unroll
                        for (int n = 0; n < 2; ++n)
#pragma unroll
                            for (int j = 0; j < 4; ++j) v[n][j] = silu_f(v[n][j]);
                    } else if (kind == 4) {
#pragma unroll
                        for (int n = 0; n < 2; ++n)
#pragma unroll
                            for (int j = 0; j < 4; ++j) { const float z = v[n][j], t = __builtin_amdgcn_exp2f(-1.44269504089f * __builtin_fabsf(z)), ri = __builtin_amdgcn_rcpf(1.0f + t);
                                const float sig = z >= 0.f ? ri : t * ri, lb = lbv[bj][n][j]; v[n][j] = __builtin_amdgcn_logf(__builtin_fmaxf(lb + (1.0f - lb) * sig, 1e-30f)); }
                    }
                    u32x4 w; w.x = cvt_pk_bf16(v[0][0], v[0][1]); w.y = cvt_pk_bf16(v[0][2], v[0][3]); w.z = cvt_pk_bf16(v[1][0], v[1][1]); w.w = cvt_pk_bf16(v[1][2], v[1][3]);
                    ST16(rowp + bj * HALF, w); } } }
    }
};
struct EpiResBf16 {
    static constexpr bool PERM = true, AFTER_DRAIN = false; static constexpr int NST = 16;
    const bf16_t* res; bf16_t* out; int ldc; float* ss; PG8_LAS float* P;
    __device__ __forceinline__ void operator()(const f32x4 (&acc)[2][2][4][2], const Unit& u, int wr, int wc, int fr, int fq) const {
        const int row0 = u.pm * BM + wr * 64 + fr, col0 = u.pn * BM + wc * 32 + 8 * fq;
#pragma unroll
        for (int ai = 0; ai < 2; ++ai) {
            u32x4 r[4][2];
#pragma unroll
            for (int m = 0; m < 4; ++m)
#pragma unroll
                for (int bj = 0; bj < 2; ++bj) r[m][bj] = *(const u32x4*)(res + (size_t)(row0 + ai * HALF + m * 16) * ldc + col0 + bj * HALF);
            asm volatile("" ::: "memory");
#pragma unroll
            for (int m = 0; m < 4; ++m) { float s = 0.f;
#pragma unroll
                for (int bj = 0; bj < 2; ++bj) { const u32x4 q = r[m][bj]; const f32x4 a0 = acc[ai][bj][m][0], a1 = acc[ai][bj][m][1]; u32x4 w;
                    w.x = cvt_pk_bf16(__uint_as_float(q.x << 16) + a0[0], __uint_as_float(q.x & 0xffff0000u) + a0[1]); w.y = cvt_pk_bf16(__uint_as_float(q.y << 16) + a0[2], __uint_as_float(q.y & 0xffff0000u) + a0[3]);
                    w.z = cvt_pk_bf16(__uint_as_float(q.z << 16) + a1[0], __uint_as_float(q.z & 0xffff0000u) + a1[1]); w.w = cvt_pk_bf16(__uint_as_float(q.w << 16) + a1[2], __uint_as_float(q.w & 0xffff0000u) + a1[3]);
                    *(u32x4*)(out + (size_t)(row0 + ai * HALF + m * 16) * ldc + col0 + bj * HALF) = w;
#pragma unroll
                    for (int e = 0; e < 4; ++e) { const float lo = __uint_as_float(w[e] << 16), hi = __uint_as_float(w[e] & 0xffff0000u); s += lo * lo + hi * hi; } }
                s += __shfl_xor(s, 16); s += __shfl_xor(s, 32);
                if (fq == 0) P[(ai * HALF + wr * 64 + m * 16 + fr) * 4 + wc] = s; }
            asm volatile("" ::: "memory");
        }
        asm volatile("s_waitcnt lgkmcnt(0)" ::: "memory"); __builtin_amdgcn_s_barrier(); asm volatile("" ::: "memory");
        const int t = (wr * 4 + wc) * 64 + fq * 16 + fr;
        if (t < BM) { const f32x4 p = *(const PG8_LAS f32x4*)(P + t * 4); ss[(size_t)(u.pm * BM + t) * 8 + u.pn] = (p[0] + p[1]) + (p[2] + p[3]); }
    }
};
struct EpiSwiGLU {
    static constexpr bool PERM = true, AFTER_DRAIN = false; static constexpr int NST = 8;
    bf16_t* H; int ldh; const float* ss; PG8_LAS float* RS;
    __device__ __forceinline__ void operator()(const f32x4 (&acc)[2][2][4][2], const Unit& u, int wr, int wc, int fr, int fq) const {
        const int row0 = u.pm * BM + wr * 64 + fr, col0 = u.pn * HALF + wc * 32 + 8 * fq;
        row_scale_table(ss, RS, u.pm, (wr * 4 + wc) * 64 + fq * 16 + fr);
#pragma unroll
        for (int ai = 0; ai < 2; ++ai) { float rs[4];
#pragma unroll
            for (int m = 0; m < 4; ++m) rs[m] = RS[4 + ai * HALF + wr * 64 + m * 16 + fr];
#pragma unroll
            for (int m = 0; m < 4; ++m) { bf16_t* rowp = H + (size_t)(row0 + ai * HALF + m * 16) * ldh + col0;
                const f32x4 g0 = acc[ai][0][m][0] * rs[m], g1 = acc[ai][0][m][1] * rs[m], u0 = acc[ai][1][m][0] * rs[m], u1 = acc[ai][1][m][1] * rs[m];
                u32x4 w; w.x = cvt_pk_bf16(silu_f(g0[0]) * u0[0], silu_f(g0[1]) * u0[1]); w.y = cvt_pk_bf16(silu_f(g0[2]) * u0[2], silu_f(g0[3]) * u0[3]);
                w.z = cvt_pk_bf16(silu_f(g1[0]) * u1[0], silu_f(g1[1]) * u1[1]); w.w = cvt_pk_bf16(silu_f(g1[2]) * u1[2], silu_f(g1[3]) * u1[3]);
                ST16(rowp, w); } }
    }
};

template <class Epi, class Sched, bool ALIGN_EPI = false, bool SP2 = false>
__device__ __forceinline__ void gemm_phase(PG8_LAS unsigned char* lds, const Gemm g, const Sched& S, const Epi& E, unsigned long long& gp_acc) {
    unsigned long long gp_t0 = 0; (void)gp_t0; (void)gp_acc;
#define GP_B(k) do { if (TPROBE == (k)) gp_t0 = __builtin_amdgcn_s_memrealtime(); } while (0)
#define GP_E(k) do { if (TPROBE == (k)) gp_acc += __builtin_amdgcn_s_memrealtime() - gp_t0; } while (0)
    int tid_ = threadIdx.x; asm volatile("" : "+v"(tid_));
    const int tid = tid_, wid = __builtin_amdgcn_readfirstlane(tid >> 6), lane = tid & 63, wr = wid >> 2, wc = wid & 3, fr = lane & 15, fq = lane >> 4;
    const int K = g.K, nt = K / BK;
    unsigned voffA[2], voffB[2];
#pragma unroll
    for (int i = 0; i < 2; ++i) { int R, C; stage_rc(tid * 16 + i * 8192, R, C); const int Rb = Epi::PERM ? ((R & ~31) + perm32(R & 31)) : R;
        voffA[i] = (unsigned)(R * K + C) * 2u; voffB[i] = (unsigned)(Rb * K + C) * 2u; }
    const size_t kstep = (size_t)(BK * 2);
    const size_t hstep = (size_t)HALF * K * 2;
    const size_t tstep = 2 * hstep;
    const unsigned ldsw = (unsigned)wid * 1024u;
    const int aoff = lds_byte(wr * 64 + fr, fq * 8), boff = lds_byte(wc * 32 + fr, fq * 8);
#define PG8_SA(b, h) (((b) * 2 + (h)) * HTB)
#define PG8_SB(b, h) ((4 + (b) * 2 + (h)) * HTB)
#define PG8_STAGE(bufoff, gbase, voff) do { _Pragma("unroll") for (int _i = 0; _i < 2; ++_i) \
        __builtin_amdgcn_global_load_lds((const unsigned*)((const char*)(gbase) + (voff)[_i]), (PG8_LAS unsigned*)(lds + (bufoff) + ldsw + _i * 8192), 16, 0, 0); } while (0)
#define PG8_LDA(dst, b, h) do { _Pragma("unroll") for (int m = 0; m < 4; ++m) _Pragma("unroll") for (int k = 0; k < 2; ++k) dst[m][k] = *(const PG8_LAS bf16x8*)(lds + PG8_SA(b, h) + aoff + m * 2048 + k * 1024); } while (0)
#define PG8_LDB(dst, b, h) do { _Pragma("unroll") for (int n = 0; n < 2; ++n) _Pragma("unroll") for (int k = 0; k < 2; ++k) dst[n][k] = *(const PG8_LAS bf16x8*)(lds + PG8_SB(b, h) + boff + n * 2048 + k * 1024); } while (0)
#define PG8_MMA(ai, bj, At, Bt) do { __builtin_amdgcn_s_setprio(1); _Pragma("unroll") for (int m = 0; m < 4; ++m) _Pragma("unroll") for (int n = 0; n < 2; ++n) _Pragma("unroll") for (int k = 0; k < 2; ++k) \
        acc[ai][bj][m][n] = __builtin_amdgcn_mfma_f32_16x16x32_bf16(Bt[n][k], At[m][k], acc[ai][bj][m][n], 0, 0, 0); __builtin_amdgcn_s_setprio(0); } while (0)
#define PG8_WAIT_V(n) asm volatile("s_waitcnt vmcnt(" #n ")" ::: "memory")
#define PG8_WAIT_V8R do { if constexpr (Epi::NST == 16) asm volatile("s_waitcnt vmcnt(24)\n\ts_cmp_lg_u32 %0, 0\n\ts_cbranch_scc1 1f\n\ts_waitcnt vmcnt(8)\n1:" :: "s"(relax) : "memory", "scc"); \
        else if constexpr (Epi::NST == 8) asm volatile("s_waitcnt vmcnt(16)\n\ts_cmp_lg_u32 %0, 0\n\ts_cbranch_scc1 1f\n\ts_waitcnt vmcnt(8)\n1:" :: "s"(relax) : "memory", "scc"); \
        else asm volatile("s_waitcnt vmcnt(8)" ::: "memory"); } while (0)
#define PG8_WAIT_L(n) asm volatile("s_waitcnt lgkmcnt(" #n ")" ::: "memory")
#define PG8_BAR __builtin_amdgcn_s_barrier()
#define PG8_SCHED __builtin_amdgcn_sched_barrier(0)
    Unit cur, nxt; int ui = 0;
    if (!S.next(0, cur)) return;
    f32x4 acc[2][2][4][2];
#pragma unroll
    for (int a = 0; a < 2; ++a)
#pragma unroll
        for (int b = 0; b < 2; ++b)
#pragma unroll
            for (int m = 0; m < 4; ++m)
#pragma unroll
                for (int n = 0; n < 2; ++n) acc[a][b][m][n] = (f32x4){0.f, 0.f, 0.f, 0.f};
    bf16x8 At[4][2], B0[2][2], B1[2][2];
    const char* cA = (const char*)g.A + (size_t)cur.pm * tstep; const char* cB = (const char*)g.Bt + (size_t)cur.pn * tstep;
    S.a_ready(cur);
    if constexpr (SP2) {
        PG8_STAGE(PG8_SB(0, 0), cB, voffB); PG8_STAGE(PG8_SB(0, 1), cB + hstep, voffB); PG8_STAGE(PG8_SA(0, 0), cA, voffA); PG8_STAGE(PG8_SA(0, 1), cA + hstep, voffA);
        if (wr == 1) PG8_BAR;
        PG8_WAIT_V(2); PG8_BAR;
        PG8_STAGE(PG8_SB(1, 0), cB + kstep, voffB); PG8_STAGE(PG8_SA(1, 0), cA + kstep, voffA); PG8_STAGE(PG8_SB(1, 1), cB + hstep + kstep, voffB);
        PG8_WAIT_V(6); PG8_BAR;
    } else {
        PG8_STAGE(PG8_SB(0, 0), cB, voffB); PG8_STAGE(PG8_SA(0, 0), cA, voffA); PG8_STAGE(PG8_SB(0, 1), cB + hstep, voffB); PG8_STAGE(PG8_SA(0, 1), cA + hstep, voffA);
        if (wr == 1) PG8_BAR;
        PG8_WAIT_V(4); PG8_BAR;
        PG8_STAGE(PG8_SB(1, 0), cB + kstep, voffB); PG8_STAGE(PG8_SA(1, 0), cA + kstep, voffA); PG8_STAGE(PG8_SB(1, 1), cB + hstep + kstep, voffB);
        PG8_WAIT_V(6); PG8_BAR;
    }
    for (;;) {
        const bool has_next = S.next(ui + 1, nxt);
        const char* nA = has_next ? (const char*)g.A + (size_t)nxt.pm * tstep : cA; const char* nB = has_next ? (const char*)g.Bt + (size_t)nxt.pn * tstep : cB;
        for (int t = 0; t < nt; t += 2) {
            const bool last = (t == nt - 2); const int relax = __builtin_amdgcn_readfirstlane((RELAX_EPI && (t == 0) && (ui > 0)) ? 1 : 0);
            const char* a1 = cA + (size_t)(t + 1) * kstep;
            const char* a2 = last ? nA : cA + (size_t)(t + 2) * kstep; const char* b2 = last ? nB : cB + (size_t)(t + 2) * kstep;
            const char* a3 = a2 + kstep; const char* b3 = b2 + kstep;
            if (last && has_next) S.a_ready(nxt);
            if (t == 0) GP_B(21); GP_B(22);
            if constexpr (SP2) {
            PG8_LDB(B0, 0, 0); PG8_LDB(B1, 0, 1); PG8_SCHED; PG8_LDA(At, 0, 0); PG8_STAGE(PG8_SA(1, 1), a1 + hstep, voffA);
            PG8_WAIT_V8R; PG8_WAIT_L(0); PG8_BAR; PG8_MMA(0, 0, At, B0); PG8_MMA(0, 1, At, B1); PG8_BAR; PG8_SCHED;
            PG8_LDA(At, 0, 1); PG8_STAGE(PG8_SB(0, 0), b2, voffB); PG8_STAGE(PG8_SB(0, 1), b2 + hstep, voffB); PG8_STAGE(PG8_SA(0, 0), a2, voffA);
            PG8_WAIT_V8R; PG8_WAIT_L(0); PG8_BAR; PG8_MMA(1, 0, At, B0); PG8_MMA(1, 1, At, B1); PG8_BAR; PG8_SCHED;
            PG8_LDB(B0, 1, 0); PG8_LDB(B1, 1, 1); PG8_SCHED; PG8_LDA(At, 1, 0); PG8_STAGE(PG8_SA(0, 1), a2 + hstep, voffA);
            PG8_WAIT_V(8); PG8_WAIT_L(0); PG8_BAR; PG8_MMA(0, 0, At, B0); PG8_MMA(0, 1, At, B1); PG8_BAR; PG8_SCHED;
            PG8_LDA(At, 1, 1); PG8_STAGE(PG8_SB(1, 0), b3, voffB); PG8_STAGE(PG8_SB(1, 1), b3 + hstep, voffB); PG8_STAGE(PG8_SA(1, 0), a3, voffA);
            PG8_WAIT_V(8); PG8_WAIT_L(0); PG8_BAR; PG8_MMA(1, 0, At, B0); PG8_MMA(1, 1, At, B1); PG8_BAR; PG8_SCHED;
            } else {
            PG8_LDB(B0, 0, 0); PG8_SCHED; PG8_LDA(At, 0, 0); PG8_STAGE(PG8_SA(1, 1), a1 + hstep, voffA);
            PG8_WAIT_L(8); PG8_BAR; PG8_WAIT_L(0); PG8_MMA(0, 0, At, B0); PG8_BAR; PG8_SCHED;
            PG8_LDB(B1, 0, 1); PG8_STAGE(PG8_SB(0, 0), b2, voffB);
            PG8_BAR; PG8_WAIT_L(0); PG8_MMA(0, 1, At, B1); PG8_BAR;
            PG8_LDA(At, 0, 1); PG8_STAGE(PG8_SA(0, 0), a2, voffA);
            PG8_BAR; PG8_WAIT_L(0); PG8_MMA(1, 0, At, B0); PG8_BAR; PG8_SCHED;
            PG8_STAGE(PG8_SB(0, 1), b2 + hstep, voffB);
            PG8_WAIT_V(6); PG8_BAR; PG8_MMA(1, 1, At, B1); PG8_BAR;
            PG8_LDB(B0, 1, 0); PG8_SCHED; PG8_LDA(At, 1, 0); PG8_STAGE(PG8_SA(0, 1), a2 + hstep, voffA);
            PG8_WAIT_L(8); PG8_BAR; PG8_WAIT_L(0); PG8_MMA(0, 0, At, B0); PG8_BAR; PG8_SCHED;
            PG8_LDB(B1, 1, 1); PG8_STAGE(PG8_SB(1, 0), b3, voffB);
            PG8_BAR; PG8_WAIT_L(0); PG8_MMA(0, 1, At, B1); PG8_BAR;
            PG8_LDA(At, 1, 1); PG8_STAGE(PG8_SA(1, 0), a3, voffA);
            PG8_BAR; PG8_WAIT_L(0); PG8_MMA(1, 0, At, B0); PG8_BAR; PG8_SCHED;
            PG8_STAGE(PG8_SB(1, 1), b3 + hstep, voffB);
            PG8_WAIT_V(6); PG8_BAR; PG8_MMA(1, 1, At, B1); PG8_BAR;
            }
            if (t == 0) GP_E(21); GP_E(22);
        }
        if constexpr (ALIGN_EPI) { if (wr == 0) PG8_BAR; }
        GP_B(20);
        if constexpr (!Epi::AFTER_DRAIN) { E(acc, cur, wr, wc, fr, fq);
#if defined(DUP_EPI) && DUP_EPI
            if constexpr (Epi::PERM) { asm volatile("" ::: "memory"); E(acc, cur, wr, wc, fr, fq); }
#endif
            S.done(cur); }
        GP_E(20);
        if (!has_next) break;
#pragma unroll
        for (int a = 0; a < 2; ++a)
#pragma unroll
            for (int b = 0; b < 2; ++b)
#pragma unroll
                for (int m = 0; m < 4; ++m)
#pragma unroll
                    for (int n = 0; n < 2; ++n) acc[a][b][m][n] = (f32x4){0.f, 0.f, 0.f, 0.f};
        cur = nxt; cA = nA; cB = nB; ++ui;
        if constexpr (ALIGN_EPI) { if (wr == 1) PG8_BAR; }
    }
    PG8_WAIT_V(0);
    if constexpr (!ALIGN_EPI) { if (wr == 0) PG8_BAR; }
    PG8_BAR;
    if constexpr (Epi::AFTER_DRAIN) { E.fused(acc, cur, wr, wc, fr, fq, lds, wid, lane); S.done(cur); }
#undef PG8_SA
#undef PG8_SB
#undef PG8_STAGE
#undef PG8_LDA
#undef PG8_LDB
#undef PG8_MMA
#undef PG8_WAIT_V
#undef PG8_WAIT_V8R
#undef PG8_WAIT_L
#undef PG8_BAR
#undef PG8_SCHED
#undef GP_B
#undef GP_E
}
}

constexpr int NWAVES = 8, NTHR = 512;
constexpr int D = 2048, BATCH = 16, SEQ = 2048, M = BATCH * SEQ, DEPTH = 4;
constexpr int DC = 1024, DH = 1024, DIN = 7168, DFF = 5632, NGU = 2 * DFF, HEADS = 8, HD = 128;
constexpr int C_B = 0, C_C = 1024, C_H = 2048, C_Q = 3072, C_Z = 4096, C_I = 5120, C_G = 6144;
constexpr float EPS = 1e-6f;
#ifndef MK_ONE_LAUNCH
#define MK_ONE_LAUNCH 1
#endif
constexpr int NPH = 2 + 5 * DEPTH;

constexpr size_t MiB = 1u << 20;
constexpr size_t WS_CTL = 0, CTL_ZERO_BYTES = 1 * MiB;
constexpr size_t WS_LB = 1 * MiB;
constexpr size_t WS_SS = 2 * MiB;
constexpr size_t WS_WIN = 3 * MiB, SZ_WIN = (size_t)DIN * D * 2;
constexpr size_t WS_WOUT = WS_WIN + DEPTH * SZ_WIN, SZ_WOUT = (size_t)D * D * 2;
constexpr size_t WS_WGU = WS_WOUT + DEPTH * SZ_WOUT, SZ_WGU = (size_t)NGU * D * 2;
constexpr size_t WS_WDN = WS_WGU + DEPTH * SZ_WGU, SZ_WDN = (size_t)D * DFF * 2;
constexpr size_t WS_HB = WS_WDN + DEPTH * SZ_WDN;
constexpr size_t WS_PROJ = WS_HB + (size_t)M * D * 2;
constexpr size_t WS_END = WS_PROJ + (size_t)M * DIN * 2;
constexpr int CW_BAR = 4096;

constexpr int RING_OFF = 0, RING_BYTES = 131072;
constexpr int MISC_OFF = RING_BYTES + 320;
constexpr int RST_OFF = RING_BYTES + 8192;
constexpr int PSS_OFF = RING_BYTES + 1024;
constexpr int LDS_BYTES = 147456;

#define GAS __attribute__((address_space(1)))
#define LAS __attribute__((address_space(3)))
typedef unsigned short bf16;
typedef unsigned v4u __attribute__((ext_vector_type(4)));
typedef unsigned v2u __attribute__((ext_vector_type(2)));
typedef float f32x4 __attribute__((ext_vector_type(4)));
#define LDS_WAIT() asm volatile("s_waitcnt lgkmcnt(0)" ::: "memory")
#define VM_WAIT() asm volatile("s_waitcnt vmcnt(0)" ::: "memory")
__device__ __forceinline__ unsigned pk2(float lo, float hi) { return pg8::cvt_pk_bf16(lo, hi); }
__device__ __forceinline__ float bf_lo(unsigned w) { return __uint_as_float(w << 16); }
__device__ __forceinline__ float bf_hi(unsigned w) { return __uint_as_float(w & 0xffff0000u); }
__device__ __forceinline__ void unpack8(const v4u r, float (&o)[8]) { o[0] = bf_lo(r.x); o[1] = bf_hi(r.x); o[2] = bf_lo(r.y); o[3] = bf_hi(r.y); o[4] = bf_lo(r.z); o[5] = bf_hi(r.z); o[6] = bf_lo(r.w); o[7] = bf_hi(r.w); }
__device__ __forceinline__ v4u pack8(const float (&o)[8]) { v4u w; w.x = pk2(o[0], o[1]); w.y = pk2(o[2], o[3]); w.z = pk2(o[4], o[5]); w.w = pk2(o[6], o[7]); return w; }
__device__ __forceinline__ float wave_sum(float v) {
#pragma unroll
    for (int o = 1; o < 64; o <<= 1) v += __shfl_xor(v, o);
    return v;
}
__device__ __forceinline__ float sum16(float v) {
#pragma unroll
    for (int o = 1; o < 16; o <<= 1) v += __shfl_xor(v, o);
    return v;
}
#define XB_TMO      128
#define XB_XCNT(j)  (256  + 64 * (j))
#define XB_XSUB(j)  (1280 + 64 * (j))
#define XB_XGEN(j)  (2304 + 64 * (j))
#define XB_TOP      3328
#define XB_TOPGEN   3392
#define XCD_BAR_WORDS 3456
#define XB_SPIN_CAP (1u << 18)

__device__ __forceinline__ unsigned xb_ld(unsigned* p)              { return __hip_atomic_load(p, __ATOMIC_RELAXED, __HIP_MEMORY_SCOPE_AGENT); }
__device__ __forceinline__ unsigned xb_add(unsigned* p, unsigned v) { return __hip_atomic_fetch_add(p, v, __ATOMIC_RELAXED, __HIP_MEMORY_SCOPE_AGENT); }
__device__ __forceinline__ unsigned xb_xcc_id() { return (unsigned)__builtin_amdgcn_s_getreg((3 << 11) | 20) & 0xFu; }
#define XB_SPIN(cond, bar) do { unsigned _sp = 0; while (cond) { __builtin_amdgcn_s_sleep(1); \
    if ((++_sp & 255u) == 0u) { if (xb_ld(&(bar)[XB_TMO])) break; if (_sp > XB_SPIN_CAP) { atomicAdd(&(bar)[XB_TMO], 1u); break; } } } } while (0)

struct XcdBarrier {
    unsigned* bar; unsigned x;
    volatile LAS unsigned* st;
};

__device__ __forceinline__ XcdBarrier xcd_barrier_post(unsigned* bar, volatile LAS unsigned* st) {
    XcdBarrier b; b.bar = bar; b.x = xb_xcc_id(); b.st = st;
    if (threadIdx.x == 0) (void)xb_add(&bar[XB_XCNT(b.x)], 1u);
    return b;
}
__device__ __forceinline__ void xcd_barrier_complete(unsigned* bar, unsigned x, unsigned& nloc, unsigned& nx) {
    const unsigned G = gridDim.x * gridDim.y * gridDim.z;
    unsigned sum, cnt, mine, sp = 0u;
    for (;;) {
        sum = 0u; cnt = 0u; mine = 0u;
#pragma unroll
        for (unsigned j = 0; j < 16; ++j) { const unsigned c = xb_ld(&bar[XB_XCNT(j)]); sum += c; cnt += (c > 0u) ? 1u : 0u; mine = (j == x) ? c : mine; }
        if (sum == G) break;
        __builtin_amdgcn_s_sleep(1);
        if ((++sp & 255u) == 0u) { if (xb_ld(&bar[XB_TMO])) break; if (sp > XB_SPIN_CAP) { atomicAdd(&bar[XB_TMO], 1u); break; } }
    }
    nloc = mine > 0u ? mine : 1u; nx = cnt > 0u ? cnt : 1u;
}

__device__ __forceinline__ void xcd_barrier(const XcdBarrier& b) {
    asm volatile("s_waitcnt vmcnt(0)" ::: "memory");
    __syncthreads();
    if (threadIdx.x == 0) {
        unsigned* bar = b.bar;
        __builtin_amdgcn_s_waitcnt(0);
        unsigned nloc = b.st[0], nx = b.st[1];
        if (nloc == 0u) { xcd_barrier_complete(bar, b.x, nloc, nx); b.st[0] = nloc; b.st[1] = nx; }
        const unsigned old = xb_add(&bar[XB_XSUB(b.x)], 1u);
        const unsigned gen = old / nloc;
        if (old + 1u == (gen + 1u) * nloc) {
            __builtin_amdgcn_fence(__ATOMIC_RELEASE, "agent");
            asm volatile("s_waitcnt vmcnt(0)" ::: "memory");
            const unsigned og = xb_add(&bar[XB_TOP], 1u);
            const unsigned tg = og / nx;
            if (og + 1u == (tg + 1u) * nx) xb_add(&bar[XB_TOPGEN], 1u);
            else XB_SPIN(xb_ld(&bar[XB_TOPGEN]) == tg, bar);
            __builtin_amdgcn_fence(__ATOMIC_ACQUIRE, "agent");
            xb_add(&bar[XB_XGEN(b.x)], 1u);
            asm volatile("s_waitcnt vmcnt(0)" ::: "memory");
        } else {
            XB_SPIN(xb_ld(&bar[XB_XGEN(b.x)]) == gen, bar);
            __builtin_amdgcn_fence(__ATOMIC_ACQUIRE, "agent");
            asm volatile("s_waitcnt vmcnt(0)" ::: "memory");
        }
    }
    __syncthreads();
}

__device__ __forceinline__ void transpose_item(const float* W, int K, int N, bf16* WT, int k0, int n0, int drow0, LAS float* scr, int lane, const float* gain) {
#pragma unroll 8
    for (int i = 0; i < 32; ++i) { const int kk = 2 * i + (lane >> 5); const float gk = gain ? gain[k0 + kk] : 1.0f; scr[kk * 33 + (lane & 31)] = W[(size_t)(k0 + kk) * N + n0 + (lane & 31)] * gk; }
    LDS_WAIT(); asm volatile("" ::: "memory");
    const int c = lane & 7;
#pragma unroll
    for (int j = 0; j < 4; ++j) { const int n = (lane >> 3) + 8 * j; const LAS float* s = scr + (8 * c) * 33 + n;
        v4u o; o.x = pk2(s[0 * 33], s[1 * 33]); o.y = pk2(s[2 * 33], s[3 * 33]); o.z = pk2(s[4 * 33], s[5 * 33]); o.w = pk2(s[6 * 33], s[7 * 33]);
        *(v4u*)(WT + (size_t)(drow0 + n) * K + k0 + 8 * c) = o; }
    LDS_WAIT(); asm volatile("" ::: "memory");
}
__device__ __forceinline__ void weights_phase(const float* w_in, const float* w_out, const float* w_gate, const float* w_up, const float* w_down, const float* norm_mix, const float* norm_ffn,
                                              unsigned char* ws, LAS unsigned char* lds, int l0, int l1, int gw, int NGW, int wave, int lane) {
    LAS float* scr = (LAS float*)(lds + RING_OFF + wave * 16384);
    constexpr int I_IN = (D / 64) * (DIN / 32), I_OUT = (D / 64) * (D / 32), I_G = (D / 64) * (DFF / 32), I_DN = (DFF / 64) * (D / 32);
    constexpr int PER_LAYER = I_IN + I_OUT + 2 * I_G + I_DN;
    for (int it = l0 * PER_LAYER + gw; it < l1 * PER_LAYER; it += NGW) {
        const int l = it / PER_LAYER; int r = it % PER_LAYER;
        if (r < I_IN) { const int nb = r % (DIN / 32), kb = r / (DIN / 32);
            transpose_item(w_in + (size_t)l * D * DIN, D, DIN, (bf16*)(ws + WS_WIN + l * SZ_WIN), kb * 64, nb * 32, nb * 32, scr, lane, norm_mix + l * D); continue; } r -= I_IN;
        if (r < I_OUT) { const int nb = r % (D / 32), kb = r / (D / 32);
            transpose_item(w_out + (size_t)l * D * D, D, D, (bf16*)(ws + WS_WOUT + l * SZ_WOUT), kb * 64, nb * 32, nb * 32, scr, lane, nullptr); continue; } r -= I_OUT;
        if (r < I_G) { const int nb = r % (DFF / 32), kb = r / (DFF / 32), n0 = nb * 32;
            transpose_item(w_gate + (size_t)l * D * DFF, D, DFF, (bf16*)(ws + WS_WGU + l * SZ_WGU), kb * 64, n0, (n0 >> 7) * 256 + (n0 & 127), scr, lane, norm_ffn + l * D); continue; } r -= I_G;
        if (r < I_G) { const int nb = r % (DFF / 32), kb = r / (DFF / 32), n0 = nb * 32;
            transpose_item(w_up + (size_t)l * D * DFF, D, DFF, (bf16*)(ws + WS_WGU + l * SZ_WGU), kb * 64, n0, (n0 >> 7) * 256 + 128 + (n0 & 127), scr, lane, norm_ffn + l * D); continue; } r -= I_G;
        { const int nb = r % (D / 32), kb = r / (D / 32);
            transpose_item(w_down + (size_t)l * DFF * D, DFF, D, (bf16*)(ws + WS_WDN + l * SZ_WDN), kb * 64, nb * 32, nb * 32, scr, lane, nullptr); }
    }
}
__device__ __forceinline__ void xconv_phase(const float* x_in, bf16* xb, float* ss, const float* lb_logits, float* lbt, int gw, int NGW, int lane, int gtid) {
    for (int m = gw; m < M; m += NGW) {
        const f32x4* xr = (const f32x4*)(x_in + (size_t)m * D) + lane; v2u* o = (v2u*)(xb + (size_t)m * D) + lane; float s = 0.f;
#pragma unroll
        for (int j = 0; j < 8; ++j) { const f32x4 v = xr[64 * j]; v2u w; w.x = pk2(v.x, v.y); w.y = pk2(v.z, v.w); o[64 * j] = w;
            const float a = bf_lo(w.x), b = bf_hi(w.x), c = bf_lo(w.y), d = bf_hi(w.y); s += (a * a + b * b) + (c * c + d * d); }
        s = wave_sum(s);
        if (lane < 8) ss[(size_t)m * 8 + lane] = lane == 0 ? s : 0.f;
    }
    if (gtid < DH) {
        float lg[DEPTH], mx = -3.0e38f;
#pragma unroll
        for (int l = 0; l < DEPTH; ++l) { lg[l] = lb_logits[l * DH + gtid]; mx = fmaxf(mx, lg[l]); }
        float den = 0.f;
#pragma unroll
        for (int l = 0; l < DEPTH; ++l) { lg[l] = __expf(lg[l] - mx); den += lg[l]; }
        float cum = 0.f; const float p0 = lg[0] / den;
#pragma unroll
        for (int l = 0; l < DEPTH; ++l) { cum += lg[l] / den; lbt[l * DH + gtid] = fminf(fmaxf(cum - p0, 0.f), 1.0f - 1e-4f); }
    }
}
__device__ __forceinline__ void final_norm_phase(const bf16* x, const float* gain, float* out, int gw, int NGW, int lane) {
    f32x4 g[8];
#pragma unroll
    for (int j = 0; j < 8; ++j) g[j] = ((const f32x4*)gain)[lane + 64 * j];
    for (int m = gw; m < M; m += NGW) {
        const v2u* xr = (const v2u*)(x + (size_t)m * D) + lane;
        f32x4 v[8]; float s = 0.f;
#pragma unroll
        for (int j = 0; j < 8; ++j) { const v2u w = xr[64 * j]; v[j] = (f32x4){bf_lo(w.x), bf_hi(w.x), bf_lo(w.y), bf_hi(w.y)}; s += (v[j].x * v[j].x + v[j].y * v[j].y) + (v[j].z * v[j].z + v[j].w * v[j].w); }
        const float rs = 1.0f / sqrtf(wave_sum(s) * (1.0f / D) + EPS);
        f32x4* o = (f32x4*)(out + (size_t)m * D) + lane;
#pragma unroll
        for (int j = 0; j < 8; ++j) o[64 * j] = v[j] * rs * g[j];
    }
}
__device__ __forceinline__ void conv_phase(const bf16* proj, const float* cw, const float* gn, bf16* mixed, int gw, int NGW, int lane) {
    constexpr int R = 16, NSTRIP = M / R;
    float w0[2][8], w1[2][8], w2[2][8], gg[2][8];
#pragma unroll
    for (int i = 0; i < 2; ++i)
#pragma unroll
        for (int e = 0; e < 8; ++e) { const int c = i * 512 + lane * 8 + e; w0[i][e] = cw[c]; w1[i][e] = cw[DC + c]; w2[i][e] = cw[2 * DC + c]; gg[i][e] = gn[c]; }
    for (int strip = gw; strip < NSTRIP; strip += NGW) {
        const int m0 = strip * R, t0 = m0 % SEQ;
        float u1[2][8], u2[2][8];
#pragma unroll
        for (int i = 0; i < 2; ++i) {
            if (t0 == 0) {
#pragma unroll
                for (int e = 0; e < 8; ++e) { u1[i][e] = 0.f; u2[i][e] = 0.f; }
            } else {
                const bf16* p1 = proj + (size_t)(m0 - 1) * DIN + i * 512 + lane * 8; const bf16* p2 = p1 - DIN;
                float c1[8], h1[8], c2[8], h2[8];
                unpack8(*(const v4u*)(p1 + C_C), c1); unpack8(*(const v4u*)(p1 + C_H), h1); unpack8(*(const v4u*)(p2 + C_C), c2); unpack8(*(const v4u*)(p2 + C_H), h2);
#pragma unroll
                for (int e = 0; e < 8; ++e) { u1[i][e] = c1[e] * h1[e]; u2[i][e] = c2[e] * h2[e]; }
            }
        }
        for (int r = 0; r < R; ++r) {
            const size_t m = (size_t)(m0 + r);
#pragma unroll
            for (int i = 0; i < 2; ++i) {
                const bf16* p = proj + m * DIN + i * 512 + lane * 8;
                float bb[8], cc[8], hh[8], y[8]; unpack8(*(const v4u*)(p + C_B), bb); unpack8(*(const v4u*)(p + C_C), cc); unpack8(*(const v4u*)(p + C_H), hh);
                float ss = 0.f;
#pragma unroll
                for (int e = 0; e < 8; ++e) { const float u0 = cc[e] * hh[e]; y[e] = bb[e] * (w0[i][e] * u2[i][e] + w1[i][e] * u1[i][e] + w2[i][e] * u0); ss += y[e] * y[e]; u2[i][e] = u1[i][e]; u1[i][e] = u0; }
                const float rs = 1.0f / sqrtf(sum16(ss) * (1.0f / 128.0f) + EPS);
#pragma unroll
                for (int e = 0; e < 8; ++e) y[e] = y[e] * rs * gg[i][e];
                *(v4u*)(mixed + m * D + i * 512 + lane * 8) = pack8(y);
            }
        }
    }
}
__device__ __forceinline__ void hgrn_fin_phase(const bf16* proj, const float* gn, bf16* mixed, int gw, int NGW, int lane) {
    float gg[2][8];
#pragma unroll
    for (int i = 0; i < 2; ++i)
#pragma unroll
        for (int e = 0; e < 8; ++e) gg[i][e] = gn[i * 512 + lane * 8 + e];
    for (int m = gw; m < M; m += NGW) {
#pragma unroll
        for (int i = 0; i < 2; ++i) {
            bf16* po = mixed + (size_t)m * D + DC + i * 512 + lane * 8;
            float o[8], g[8]; unpack8(*(const v4u*)po, o); unpack8(*(const v4u*)(proj + (size_t)m * DIN + C_G + i * 512 + lane * 8), g);
            float ss = 0.f;
#pragma unroll
            for (int e = 0; e < 8; ++e) ss += o[e] * o[e];
            const float rs = 1.0f / sqrtf(sum16(ss) * (1.0f / 128.0f) + EPS);
#pragma unroll
            for (int e = 0; e < 8; ++e) o[e] = o[e] * rs * gg[i][e] * g[e];
            *(v4u*)po = pack8(o);
        }
    }
}

typedef short bf16x8_t __attribute__((ext_vector_type(8)));
typedef short s16x4_t __attribute__((ext_vector_type(4)));
typedef short v4i16_t __attribute__((ext_vector_type(4)));
typedef float f32x16 __attribute__((ext_vector_type(16)));
typedef float f32x2_t __attribute__((ext_vector_type(2)));
typedef __bf16 bf16x2_t __attribute__((ext_vector_type(2)));
__device__ __forceinline__ unsigned cvtpk(float lo, float hi) { f32x2_t v = {lo, hi}; bf16x2_t b = __builtin_convertvector(v, bf16x2_t); return __builtin_bit_cast(unsigned, b); }
__device__ __forceinline__ s16x4_t tr_read(const LAS unsigned char* p) { return __builtin_bit_cast(s16x4_t, __builtin_amdgcn_ds_read_tr16_b64_v4i16((LAS v4i16_t*)p)); }
__device__ __forceinline__ constexpr int crow_c(int i, int h) { return (i & 3) + 8 * (i >> 2) + 4 * h; }
#define HG_BAR() do { asm volatile("s_waitcnt lgkmcnt(0)" ::: "memory"); __builtin_amdgcn_s_barrier(); asm volatile("" ::: "memory"); } while (0)
#define MFMA32(a, b, c) __builtin_amdgcn_mfma_f32_32x32x16_bf16((a), (b), (c), 0, 0, 0)
constexpr int HG_RS = 272, HG_TS = 144, HG_VS = 320;
constexpr int HG_QD = 0, HG_Q1 = HG_QD + 64 * HG_RS, HG_K0 = HG_Q1 + 32 * HG_RS, HG_K1 = HG_K0 + 32 * HG_RS, HG_K1T = HG_K1 + 64 * HG_RS, HG_VN = HG_K1T + 128 * HG_TS,
              HG_SBT = HG_VN + 64 * HG_VS, HG_NRM = HG_SBT + 128 * HG_RS, HG_TOT = HG_NRM + 64 * 4 * 4, HG_END = HG_TOT + 8 * 128 * 4;
constexpr int HG_D1 = RING_BYTES + 9472, HG_D2 = HG_D1 + 512;
static_assert(HG_END <= RING_BYTES && HG_D2 + 512 <= LDS_BYTES && (HG_Q1 % 16) == 0 && (HG_K1T % 16) == 0 && (HG_VN % 16) == 0 && (HG_SBT % 16) == 0 && (HG_NRM % 16) == 0 && (HG_TOT % 16) == 0, "HGRN LDS map");
__device__ __forceinline__ bf16x8_t pack_step(const f32x16& x, int s) {
    v4u p; p.x = cvtpk(x[8 * s], x[8 * s + 1]); p.y = cvtpk(x[8 * s + 2], x[8 * s + 3]); p.z = cvtpk(x[8 * s + 4], x[8 * s + 5]); p.w = cvtpk(x[8 * s + 6], x[8 * s + 7]);
    return __builtin_bit_cast(bf16x8_t, p);
}
__device__ __forceinline__ void hgrn_chunk_phase(const bf16* proj, const float* gn, bf16* mixed, int nitems, int item0, int istride, LAS unsigned char* lds, int tid, int wave, int lane) {
    const int r = lane & 31, h = lane >> 5;
    const int tt = wave >> 2, vt = wave & 3;
    const int kt = wave >> 1, vs = 2 * (wave & 1);
    for (int item = item0; item < nitems; item += istride) {
        const int b = item >> 3, hd = item & 7;
        f32x16 S0, S1;
#pragma unroll
        for (int i = 0; i < 16; ++i) { S0[i] = 0.f; S1[i] = 0.f; }
        float gnv[4][4];
#pragma unroll
        for (int g = 0; g < 4; ++g)
#pragma unroll
            for (int j = 0; j < 4; ++j) gnv[g][j] = gn[hd * HD + vt * 32 + 8 * g + 4 * h + j];
        const bf16* pz = proj + (size_t)(b * SEQ + 8 * wave) * DIN + C_Z + hd * HD + 2 * lane;
        const bf16* pq = proj + (size_t)(b * SEQ + 8 * wave) * DIN + C_Q + hd * HD + 2 * lane;
        const bf16* pv = proj + (size_t)(b * SEQ + 8 * wave) * DIN + C_I + hd * HD + 2 * lane;
        const bf16* pg = proj + (size_t)(b * SEQ + tt * 32 + r) * DIN + C_G + hd * HD + vt * 32 + 4 * h;
        unsigned rz[8], rq[8], rv[8];
#pragma unroll
        for (int i = 0; i < 8; ++i) { rz[i] = *(const unsigned*)(pz + (size_t)i * DIN); rq[i] = *(const unsigned*)(pq + (size_t)i * DIN); rv[i] = *(const unsigned*)(pv + (size_t)i * DIN); }
        for (int c = 0; c < SEQ / 64; ++c) {
            float bl[8][2], kk[8][2], qs[8][2];
#pragma unroll
            for (int i = 0; i < 8; ++i) {
#pragma unroll
                for (int e = 0; e < 2; ++e) {
                    const float l2 = e ? bf_hi(rz[i]) : bf_lo(rz[i]);
                    qs[i][e] = e ? bf_hi(rq[i]) : bf_lo(rq[i]);
                    kk[i][e] = 1.0f - __builtin_amdgcn_exp2f(l2);
                    bl[i][e] = (i == 0) ? l2 : bl[i - 1][e] + l2;
                }
            }
            const size_t onext = (size_t)(c + 1 < SEQ / 64 ? c + 1 : c) * 64 * DIN;
#pragma unroll
            for (int i = 0; i < 8; ++i) { rz[i] = *(const unsigned*)(pz + onext + (size_t)i * DIN); rq[i] = *(const unsigned*)(pq + onext + (size_t)i * DIN); }
            *(LAS f32x2_t*)(lds + HG_TOT + (wave * 128 + 2 * lane) * 4) = (f32x2_t){bl[7][0], bl[7][1]};
            HG_BAR();
            float off[2] = {0.f, 0.f}, b31[2] = {0.f, 0.f}, b63[2] = {0.f, 0.f};
#pragma unroll
            for (int w = 0; w < 8; ++w) { const f32x2_t tw = *(const LAS f32x2_t*)(lds + HG_TOT + (w * 128 + 2 * lane) * 4);
                if (w < wave) { off[0] += tw.x; off[1] += tw.y; } if (w < 4) { b31[0] += tw.x; b31[1] += tw.y; } b63[0] += tw.x; b63[1] += tw.y; }
            const bool up = wave >= 4;
            unsigned k1t[2][4];
#pragma unroll
            for (int i = 0; i < 8; ++i) {
                const int t = 8 * wave + i;
                float qd[2], x2[2], k1[2];
#pragma unroll
                for (int e = 0; e < 2; ++e) { const float bt = off[e] + bl[i][e];
                    qd[e] = qs[i][e] * __builtin_amdgcn_exp2f(bt);
                    x2[e] = (up ? qs[i][e] : kk[i][e]) * __builtin_amdgcn_exp2f(up ? bt - b31[e] : fminf(-bt, 115.0f));
                    k1[e] = kk[i][e] * __builtin_amdgcn_exp2f(fminf(b31[e] - bt, 115.0f)); }
                *(LAS unsigned*)(lds + HG_QD + t * HG_RS + 4 * lane) = cvtpk(qd[0], qd[1]);
                *(LAS unsigned*)(lds + (up ? HG_Q1 + (t - 32) * HG_RS : HG_K0 + t * HG_RS) + 4 * lane) = cvtpk(x2[0], x2[1]);
                const unsigned kp = cvtpk(k1[0], k1[1]);
                *(LAS unsigned*)(lds + HG_K1 + t * HG_RS + 4 * lane) = kp;
                if ((i & 1) == 0) { k1t[0][i >> 1] = kp & 0xffffu; k1t[1][i >> 1] = kp >> 16; }
                else { k1t[0][i >> 1] |= kp << 16; k1t[1][i >> 1] |= kp & 0xffff0000u; }
            }
            *(LAS v4u*)(lds + HG_K1T + (2 * lane) * HG_TS + 16 * wave) = (v4u){k1t[0][0], k1t[0][1], k1t[0][2], k1t[0][3]};
            *(LAS v4u*)(lds + HG_K1T + (2 * lane + 1) * HG_TS + 16 * wave) = (v4u){k1t[1][0], k1t[1][1], k1t[1][2], k1t[1][3]};
            if (wave == 0) { *(LAS f32x2_t*)(lds + HG_D1 + 8 * lane) = (f32x2_t){__builtin_amdgcn_exp2f(b31[0]), __builtin_amdgcn_exp2f(b31[1])};
                             *(LAS f32x2_t*)(lds + HG_D2 + 8 * lane) = (f32x2_t){__builtin_amdgcn_exp2f(b63[0] - b31[0]), __builtin_amdgcn_exp2f(b63[1] - b31[1])}; }
#pragma unroll
            for (int i = 0; i < 8; ++i) *(LAS unsigned*)(lds + HG_VN + (8 * wave + i) * HG_VS + 4 * lane) = rv[i];
#pragma unroll
            for (int i = 0; i < 8; ++i) rv[i] = *(const unsigned*)(pv + onext + (size_t)i * DIN);
            {
#pragma unroll
                for (int g = 0; g < 4; ++g) {
                    *(LAS v2u*)(lds + HG_SBT + (vs * 32 + r) * HG_RS + (kt * 32 + 8 * g + 4 * h) * 2) = (v2u){cvtpk(S0[4 * g], S0[4 * g + 1]), cvtpk(S0[4 * g + 2], S0[4 * g + 3])};
                    *(LAS v2u*)(lds + HG_SBT + (vs * 32 + 32 + r) * HG_RS + (kt * 32 + 8 * g + 4 * h) * 2) = (v2u){cvtpk(S1[4 * g], S1[4 * g + 1]), cvtpk(S1[4 * g + 2], S1[4 * g + 3])};
                }
            }
            v2u rg[4];
#pragma unroll
            for (int g = 0; g < 4; ++g) rg[g] = *(const v2u*)(pg + (size_t)c * 64 * DIN + 8 * g);
            HG_BAR();
            f32x16 acc;
            {
                f32x16 X0, X1;
#pragma unroll
                for (int i = 0; i < 16; ++i) { X0[i] = 0.f; X1[i] = 0.f; acc[i] = 0.f; }
                const LAS unsigned char* pa_s = lds + HG_SBT + (vt * 32 + r) * HG_RS + 16 * h;
                const LAS unsigned char* pb_q = lds + HG_QD + (tt * 32 + r) * HG_RS + 16 * h;
                if (tt == 0) {
                    const LAS unsigned char* pa_k = lds + HG_K0 + r * HG_RS + 16 * h;
#pragma unroll
                    for (int ks = 0; ks < 8; ++ks) { const bf16x8_t bq = *(const LAS bf16x8_t*)(pb_q + 32 * ks);
                        X0 = MFMA32(*(const LAS bf16x8_t*)(pa_k + 32 * ks), bq, X0);
                        acc = MFMA32(*(const LAS bf16x8_t*)(pa_s + 32 * ks), bq, acc); }
#pragma unroll
                    for (int i = 0; i < 16; ++i) if (crow_c(i, h) > r) X0[i] = 0.f;
                } else {
                    const LAS unsigned char* pb_1 = lds + HG_Q1 + r * HG_RS + 16 * h;
                    const LAS unsigned char* pa_k = lds + HG_K1 + r * HG_RS + 16 * h;
#pragma unroll
                    for (int ks = 0; ks < 8; ++ks) { const bf16x8_t b1 = *(const LAS bf16x8_t*)(pb_1 + 32 * ks);
                        X0 = MFMA32(*(const LAS bf16x8_t*)(pa_k + 32 * ks), b1, X0);
                        X1 = MFMA32(*(const LAS bf16x8_t*)(pa_k + 32 * HG_RS + 32 * ks), b1, X1);
                        acc = MFMA32(*(const LAS bf16x8_t*)(pa_s + 32 * ks), *(const LAS bf16x8_t*)(pb_q + 32 * ks), acc); }
#pragma unroll
                    for (int i = 0; i < 16; ++i) if (crow_c(i, h) > r) X1[i] = 0.f;
                }
                const LAS unsigned char* pvt = lds + HG_VN + (4 * h + ((lane & 15) >> 2)) * HG_VS + (vt * 32 + ((lane >> 4) & 1) * 16 + (lane & 3) * 4) * 2;
#pragma unroll
                for (int s2 = 0; s2 < 2; ++s2) {
                    const s16x4_t lo = tr_read(pvt + (16 * s2) * HG_VS), hi = tr_read(pvt + (16 * s2 + 8) * HG_VS);
                    acc = MFMA32(__builtin_shufflevector(lo, hi, 0, 1, 2, 3, 4, 5, 6, 7), pack_step(X0, s2), acc);
                }
                if (tt == 1) {
#pragma unroll
                    for (int s2 = 0; s2 < 2; ++s2) {
                        const s16x4_t lo = tr_read(pvt + (32 + 16 * s2) * HG_VS), hi = tr_read(pvt + (32 + 16 * s2 + 8) * HG_VS);
                        acc = MFMA32(__builtin_shufflevector(lo, hi, 0, 1, 2, 3, 4, 5, 6, 7), pack_step(X1, s2), acc);
                    }
                }
            }
            {
                float ssq = 0.f;
#pragma unroll
                for (int i = 0; i < 16; ++i) ssq += acc[i] * acc[i];
                ssq += __shfl_xor(ssq, 32);
                if (h == 0) *(LAS float*)(lds + HG_NRM + ((tt * 32 + r) * 4 + vt) * 4) = ssq;
            }
            {
                f32x4 d1[4], d2[4];
#pragma unroll
                for (int g = 0; g < 4; ++g) { d1[g] = *(const LAS f32x4*)(lds + HG_D1 + (kt * 32 + 8 * g + 4 * h) * 4); d2[g] = *(const LAS f32x4*)(lds + HG_D2 + (kt * 32 + 8 * g + 4 * h) * 4); }
#pragma unroll
                for (int i = 0; i < 16; ++i) { S0[i] *= d1[i >> 2][i & 3]; S1[i] *= d1[i >> 2][i & 3]; }
                const LAS unsigned char* pa = lds + HG_K1T + (kt * 32 + r) * HG_TS + 16 * h;
                const LAS unsigned char* pvn = lds + HG_VN + (8 * h + ((lane & 15) >> 2)) * HG_VS + (vs * 32 + ((lane >> 4) & 1) * 16 + (lane & 3) * 4) * 2;
#pragma unroll
                for (int ks = 0; ks < 4; ++ks) {
                    const bf16x8_t a = *(const LAS bf16x8_t*)(pa + 32 * ks);
                    const s16x4_t l0 = tr_read(pvn + (16 * ks) * HG_VS), h0 = tr_read(pvn + (16 * ks + 4) * HG_VS);
                    const s16x4_t l1 = tr_read(pvn + (16 * ks) * HG_VS + 64), h1 = tr_read(pvn + (16 * ks + 4) * HG_VS + 64);
                    S0 = MFMA32(a, __builtin_shufflevector(l0, h0, 0, 1, 2, 3, 4, 5, 6, 7), S0);
                    S1 = MFMA32(a, __builtin_shufflevector(l1, h1, 0, 1, 2, 3, 4, 5, 6, 7), S1);
                }
#pragma unroll
                for (int i = 0; i < 16; ++i) { S0[i] *= d2[i >> 2][i & 3]; S1[i] *= d2[i >> 2][i & 3]; }
            }
            HG_BAR();
            {
                const f32x4 pn = *(const LAS f32x4*)(lds + HG_NRM + (tt * 32 + r) * 16);
                const float rs = 1.0f / sqrtf(((pn[0] + pn[1]) + (pn[2] + pn[3])) * (1.0f / 128.0f) + EPS);
                bf16* po = mixed + (size_t)(b * SEQ + c * 64 + tt * 32 + r) * D + DC + hd * HD + vt * 32 + 4 * h;
#pragma unroll
                for (int g = 0; g < 4; ++g) { const float g0 = bf_lo(rg[g].x), g1 = bf_hi(rg[g].x), g2 = bf_lo(rg[g].y), g3 = bf_hi(rg[g].y);
                    *(v2u*)(po + 8 * g) = (v2u){cvtpk(acc[4 * g] * rs * gnv[g][0] * g0, acc[4 * g + 1] * rs * gnv[g][1] * g1), cvtpk(acc[4 * g + 2] * rs * gnv[g][2] * g2, acc[4 * g + 3] * rs * gnv[g][3] * g3)}; }
            }
        }
    }
}

#ifndef DUP_GOUT
#define DUP_GOUT 0
#endif
#ifndef DUP_NORM
#define DUP_NORM 0
#endif
#ifndef DUP_GIN
#define DUP_GIN 0
#endif
#ifndef DUP_REC
#define DUP_REC 0
#endif
#ifndef DUP_CONV
#define DUP_CONV 0
#endif
#ifndef DUP_GGU
#define DUP_GGU 0
#endif
#ifndef DUP_PRO
#define DUP_PRO 0
#endif
__device__ __forceinline__ void stagger(int bx, int ng, int dticks) {
    const int g = (bx >> 3) % ng; if (g == 0 || dticks == 0) return;
    const unsigned long long t0 = __builtin_amdgcn_s_memrealtime(), dt = (unsigned long long)(g * dticks);
    while (__builtin_amdgcn_s_memrealtime() - t0 < dt) __builtin_amdgcn_s_sleep(8);
}
#ifndef STG_NG
#define STG_NG 4
#endif
#ifndef STG_IN
#define STG_IN 0
#endif
#ifndef STG_OUT
#define STG_OUT 0
#endif
#ifndef STG_GU
#define STG_GU 0
#endif
#ifndef STG_DN
#define STG_DN 0
#endif
struct FixedOrder { int n;
    __device__ bool next(int i, pg8::Unit& u) const { if (i >= n) return false; u.pm = 0; u.pn = 0; return true; }
    __device__ __forceinline__ void a_ready(const pg8::Unit&) const {}
    __device__ __forceinline__ void done(const pg8::Unit&) const {} };
#ifndef PROBE_HALF
#define PROBE_HALF 0
#endif
#ifndef PROBE_FIXED
#define PROBE_FIXED 0
#endif
#ifndef TPROBE
#define TPROBE 0
#endif
#ifndef TP_BLOCK
#define TP_BLOCK 0
#endif
#ifndef TP_MAG
#define TP_MAG 4
#endif
#define TP_B(k) do { if (TPROBE == (k)) tp_t0 = __builtin_amdgcn_s_memrealtime(); } while (0)
#define TP_E(k) do { if (TPROBE == (k)) tp_acc += __builtin_amdgcn_s_memrealtime() - tp_t0; } while (0)
struct Args { const float* in[13]; float* out; unsigned char* ws; int ph_lo, ph_hi; };
__global__ void __launch_bounds__(NTHR, 2) fwd(Args args) {
    extern __shared__ __attribute__((aligned(16))) unsigned char lds_raw[];
    LAS unsigned char* lds = (LAS unsigned char*)lds_raw;
    volatile LAS unsigned* MISC = (volatile LAS unsigned*)(lds + MISC_OFF);
    const int tid = threadIdx.x, lane = tid & 63, wave = __builtin_amdgcn_readfirstlane(tid >> 6);
    const int G = gridDim.x, bx = blockIdx.x, vcu = (G % 8 == 0) ? (bx % 8) * (G / 8) + bx / 8 : bx;
    const int gw = vcu * NWAVES + wave, NGW = G * NWAVES, gtid = vcu * NTHR + tid;
    unsigned char* ws = args.ws;
    unsigned* ctl = (unsigned*)(ws + WS_CTL);
    if (tid < 32) MISC[tid] = 0u;
    __syncthreads();
#if MK_ONE_LAUNCH
    XcdBarrier bar = xcd_barrier_post(ctl + CW_BAR, MISC + 8);
#define GRID_BAR() do { TP_B(1); xcd_barrier(bar); TP_E(1); } while (0)
#else
#define GRID_BAR() do { } while (0)
#endif
    const float* x_in = args.in[0]; const float* norm_mix = args.in[1]; const float* w_in = args.in[2]; const float* conv_w = args.in[3]; const float* gn_conv = args.in[4];
    const float* lb_logits = args.in[5]; const float* gn_hgrn = args.in[6]; const float* w_out = args.in[7]; const float* norm_ffn = args.in[8];
    const float* w_gate = args.in[9]; const float* w_up = args.in[10]; const float* w_down = args.in[11]; const float* norm_final = args.in[12];
    float* out = args.out;
    bf16* HB = (bf16*)(ws + WS_HB); bf16* PROJ = (bf16*)(ws + WS_PROJ);
    const float* LBT = (const float*)(ws + WS_LB);
    const int lo = args.ph_lo, hi = args.ph_hi;
    unsigned long long tp_t0 = 0, tp_acc = 0; (void)tp_t0; (void)tp_acc;
#define IN(k) (lo <= (k) && (k) < hi)
#define SEAM(k) do { if (IN((k) + 1)) GRID_BAR(); } while (0)

    bf16* XB = (bf16*)((unsigned char*)out + (size_t)M * D * 2);
    float* SS = (float*)(ws + WS_SS);
    LAS float* PSS = (LAS float*)(lds + PSS_OFF); LAS float* RST = (LAS float*)(lds + RST_OFF);
    if (IN(0)) { TP_B(10);
        weights_phase(w_in, w_out, w_gate, w_up, w_down, norm_mix, norm_ffn, ws, lds, 0, DEPTH, gw, NGW, wave, lane);
        xconv_phase(x_in, XB, SS, lb_logits, (float*)(ws + WS_LB), gw, NGW, lane, gtid);
        TP_E(10); SEAM(0); }
    for (int l = 0; l < DEPTH; ++l) {
        const int p = 1 + 5 * l;
        int tq = threadIdx.x; asm volatile("" : "+v"(tq));
        const int tid = tq, lane = tq & 63;
        if (IN(p + 0)) {
            TP_B(4);
            pg8::Gemm g{XB, (const bf16*)(ws + WS_WIN + l * SZ_WIN), M, DIN, D}; pg8::StaticOrder S; S.init(M, DIN, G, bx); pg8::EpiProj E{PROJ, DIN, LBT + l * DH, SS, RST};
            if (tid == 0) RST[0] = 0.f; __syncthreads();
            pg8::gemm_phase<pg8::EpiProj, pg8::StaticOrder, PG8_ALIGNV, PG8_SP2V>(lds + RING_OFF, g, S, E, tp_acc);
#if PROBE_FIXED
            {
                const bool active = PROBE_HALF == 0 ? true : (PROBE_HALF == 1 ? (bx & 7) < 4 : ((bx >> 3) & 1) == 0);
                if (active) { pg8::StaticOrder S2; S2.init(M, DIN, G, bx); S2.fixed = 14; pg8::EpiProj E2{(bf16*)(ws + WS_END) + (size_t)bx * 65536, 256, LBT + l * DH, SS, RST};
                    pg8::gemm_phase<pg8::EpiProj, pg8::StaticOrder, PG8_ALIGNV, PG8_SP2V>(lds + RING_OFF, g, S2, E2, tp_acc); } }
#endif
            TP_E(4); SEAM(p + 0); }
        if (IN(p + 1)) {
            const int idx = (bx & 7) + 8 * (bx >> 4);
            if (((bx >> 3) & 1) == 0) { TP_B(7); hgrn_chunk_phase(PROJ, gn_hgrn + l * DH, HB, BATCH * HEADS, idx, G >> 1, lds + RING_OFF, tid, wave, lane); TP_E(7); }
            else { TP_B(8); const int gwc = ((idx & 7) * (G >> 4) + (idx >> 3)) * NWAVES + wave, ngwc = (G >> 1) * NWAVES;
                conv_phase(PROJ, conv_w + l * 3 * DC, gn_conv + l * DC, HB, gwc, ngwc, lane);
                TP_E(8); }
            SEAM(p + 1); }
        if (IN(p + 2)) {
            TP_B(3);
            pg8::Gemm g{HB, (const bf16*)(ws + WS_WOUT + l * SZ_WOUT), M, D, D}; pg8::StaticOrder S; S.init(M, D, G, bx); pg8::EpiResBf16 E{XB, XB, D, SS, PSS};
            pg8::gemm_phase<pg8::EpiResBf16, pg8::StaticOrder, true, PG8_SP2V>(lds + RING_OFF, g, S, E, tp_acc);
            TP_E(3); SEAM(p + 2); }
        if (IN(p + 3)) {
            TP_B(5);
            pg8::Gemm g{XB, (const bf16*)(ws + WS_WGU + l * SZ_WGU), M, NGU, D}; pg8::StaticOrder S; S.init(M, NGU, G, bx); pg8::EpiSwiGLU E{PROJ, DFF, SS, RST};
            if (tid == 0) RST[0] = 0.f; __syncthreads();
            pg8::gemm_phase<pg8::EpiSwiGLU, pg8::StaticOrder, PG8_ALIGNV, PG8_SP2V>(lds + RING_OFF, g, S, E, tp_acc);
            TP_E(5); SEAM(p + 3); }
        if (IN(p + 4)) {
            TP_B(2);
            pg8::Gemm g{PROJ, (const bf16*)(ws + WS_WDN + l * SZ_WDN), M, D, DFF}; pg8::StaticOrder S; S.init(M, D, G, bx); pg8::EpiResBf16 E{XB, l == DEPTH - 1 ? HB : XB, D, SS, PSS};
            pg8::gemm_phase<pg8::EpiResBf16, pg8::StaticOrder, true, PG8_SP2V>(lds + RING_OFF, g, S, E, tp_acc);
            TP_E(2); SEAM(p + 4); }
    }
    if (IN(NPH - 1)) { TP_B(11); final_norm_phase(HB, norm_final, out, gw, NGW, lane); TP_E(11); }
#if TPROBE
    if (bx == TP_BLOCK && tid == 0) { const unsigned long long t0 = __builtin_amdgcn_s_memrealtime(), dt = tp_acc * TP_MAG; while (__builtin_amdgcn_s_memrealtime() - t0 < dt) __builtin_amdgcn_s_sleep(16); }
#endif
#undef IN
#undef SEAM
}

extern "C" void kernel_launch(void* const* d_in, const int* in_sizes, int n_in, void* d_out, int out_size, void* d_ws, size_t ws_size, hipStream_t stream) {
    static int grid = 0;
    if (grid == 0) {
        if (n_in != 13 || in_sizes[0] != M * D || out_size != M * D || ws_size < WS_END) { fprintf(stderr, "kernel_launch: unexpected shapes (n_in %d, in0 %d, out %d, ws %zu < %zu); nothing launched\n", n_in, n_in > 0 ? in_sizes[0] : -1, out_size, ws_size, (size_t)WS_END); grid = -1; return; }
        int dev = 0, cus = 0;
        if (hipGetDevice(&dev) != hipSuccess || hipDeviceGetAttribute(&cus, hipDeviceAttributeMultiprocessorCount, dev) != hipSuccess) { grid = -1; return; }
        if (hipFuncSetAttribute((const void*)fwd, hipFuncAttributeMaxDynamicSharedMemorySize, LDS_BYTES) != hipSuccess) { fprintf(stderr, "kernel_launch: hipFuncSetAttribute failed\n"); grid = -1; return; }
        (void)hipGetLastError();
        grid = cus;
    }
    if (grid < 0) return;
    (void)hipMemsetAsync((char*)d_ws + WS_CTL, 0, CTL_ZERO_BYTES, stream);
    Args a{};
    for (int i = 0; i < 13; ++i) a.in[i] = (const float*)d_in[i];
    a.out = (float*)d_out; a.ws = (unsigned char*)d_ws;
#if MK_ONE_LAUNCH
    a.ph_lo = 0; a.ph_hi = NPH;
    hipLaunchKernelGGL(fwd, dim3(grid), dim3(NTHR), LDS_BYTES, stream, a);
#else
    for (int p = 0; p < NPH; ++p) { a.ph_lo = p; a.ph_hi = p + 1; hipLaunchKernelGGL(fwd, dim3(grid), dim3(NTHR), LDS_BYTES, stream, a); }
#endif
}
```

```cpp
#include <hip/hip_runtime.h>
#include <cstdio>
#include <cstdint>
#define MK_ONE_LAUNCH 1
#define PG8_WGM 4
#ifndef RELAX_EPI
#define RELAX_EPI 1
#endif
#ifndef PG8_WGM
#define PG8_WGM 8
#endif
#ifndef PG8_SP2V
#define PG8_SP2V true
#endif
#ifndef PG8_ALIGNV
#define PG8_ALIGNV true
#endif
#ifndef TPROBE
#define TPROBE 0
#endif
namespace pg8 {
#define PG8_LAS __attribute__((address_space(3)))
typedef unsigned short bf16_t;
typedef short bf16x8 __attribute__((ext_vector_type(8)));
typedef float f32x4 __attribute__((ext_vector_type(4)));
typedef unsigned u32x4 __attribute__((ext_vector_type(4)));
constexpr int BM = 256, BK = 64, HALF = 128, HTB = HALF * BK * 2  , STAGE_BYTES = 8 * HTB, NXCD = 8, WGM = PG8_WGM;

__host__ __device__ __forceinline__ int lds_byte(int r, int c) { const int st = (r >> 4) * 2 + (c >> 5), rr = r & 15, cc = c & 31, ob = rr * 64 + cc * 2; return st * 1024 + (ob ^ (((ob >> 9) & 1) << 5)); }
__host__ __device__ __forceinline__ void stage_rc(int b, int& R, int& C) { const int st = b / 1024, sb = b % 1024, swz = sb ^ (((sb >> 9) & 1) << 5); R = (st >> 1) * 16 + swz / 64; C = (st & 1) * 32 + (swz % 64) / 2; }
__host__ __device__ __forceinline__ int perm32(int rho) { const int n = rho >> 4, i = rho & 15; return 8 * (i >> 2) + 4 * n + (i & 3); }

struct Unit { int pm, pn; };
struct Gemm { const bf16_t* A; const bf16_t* Bt; int M, N, K; };

struct StaticOrder {
    int nM, nN, nwg, G, c; int fixed = 0;
    __host__ __device__ void init(int M, int N, int G_, int c_) { nM = M / BM; nN = N / BM; nwg = nM * nN; G = G_; c = c_; }
    __host__ __device__ bool next(int i, Unit& u) const {
        if (fixed) { if (i >= fixed) return false; u.pm = 0; u.pn = 0; return true; }
        const long L = (long)i * G + c; if (L >= nwg) return false;
        int wgid = (int)L; { const int q = nwg / NXCD, r = nwg % NXCD, xcd = wgid % NXCD, off = wgid / NXCD; wgid = (xcd < r ? xcd * (q + 1) : r * (q + 1) + (xcd - r) * q) + off; }
        const int nig = WGM * nN, gid = wgid / nig, fm = gid * WGM, gsz = (nM - fm) < WGM ? (nM - fm) : WGM;
        u.pm = fm + ((wgid % nig) % gsz); u.pn = (wgid % nig) / gsz; return true;
    }
    __device__ __forceinline__ void a_ready(const Unit&) const {}
    __device__ __forceinline__ void done(const Unit&) const {}
};

__device__ __forceinline__ unsigned cvt_pk_bf16(float lo, float hi) { unsigned r; asm volatile("v_cvt_pk_bf16_f32 %0, %1, %2" : "=v"(r) : "v"(lo), "v"(hi)); return r; }
typedef float f32x2 __attribute__((ext_vector_type(2)));
#if defined(NT_STORES) && NT_STORES
#define ST16(p, v) __builtin_nontemporal_store((v), (u32x4*)(p))
#else
#define ST16(p, v) (*(u32x4*)(p) = (v))
#endif
__device__ __forceinline__ float silu_f(float x) { return x * __builtin_amdgcn_rcpf(1.0f + __builtin_amdgcn_exp2f(-1.44269504089f * x)); }
__device__ __forceinline__ void row_scale_table(const float* ss, PG8_LAS float* RS, int pm, int t) {
    const int tag = __builtin_amdgcn_readfirstlane(__float_as_int(RS[0]));
    if (tag != pm + 1) {
        asm volatile("s_waitcnt lgkmcnt(0)" ::: "memory"); __builtin_amdgcn_s_barrier(); asm volatile("" ::: "memory");
        if (t < BM) { const f32x4* p = (const f32x4*)(ss + (size_t)(pm * BM + t) * 8); const f32x4 a = p[0], b = p[1];
            RS[4 + t] = 1.0f / __builtin_sqrtf((((a[0] + a[1]) + (a[2] + a[3])) + ((b[0] + b[1]) + (b[2] + b[3]))) * (1.0f / 2048.0f) + 1e-6f);
            if (t == 0) RS[0] = __int_as_float(pm + 1); }
        asm volatile("s_waitcnt lgkmcnt(0)" ::: "memory"); __builtin_amdgcn_s_barrier(); asm volatile("" ::: "memory");
    }
}
struct EpiBf16Plain {
    static constexpr bool PERM = true, AFTER_DRAIN = false; static constexpr int NST = 16;
    bf16_t* O; int ldc;
    __device__ __forceinline__ void operator()(const f32x4 (&acc)[2][2][4][2], const Unit& u, int wr, int wc, int fr, int fq) const {
        const int row0 = u.pm * BM + wr * 64 + fr, col0 = u.pn * BM + wc * 32 + 8 * fq;
#pragma unroll
        for (int ai = 0; ai < 2; ++ai)
#pragma unroll
            for (int m = 0; m < 4; ++m) { bf16_t* rowp = O + (size_t)(row0 + ai * HALF + m * 16) * ldc + col0;
#pragma unroll
                for (int bj = 0; bj < 2; ++bj) { const f32x4 v0 = acc[ai][bj][m][0], v1 = acc[ai][bj][m][1];
                    u32x4 w; w.x = cvt_pk_bf16(v0[0], v0[1]); w.y = cvt_pk_bf16(v0[2], v0[3]); w.z = cvt_pk_bf16(v1[0], v1[1]); w.w = cvt_pk_bf16(v1[2], v1[3]);
                    *(u32x4*)(rowp + bj * HALF) = w; } }
    }
};
struct EpiProj {
    static constexpr bool PERM = true, AFTER_DRAIN = false; static constexpr int NST = 16;
    bf16_t* O; int ldc; const float* lbt; const float* ss; PG8_LAS float* RS;
    __device__ __forceinline__ void operator()(const f32x4 (&acc)[2][2][4][2], const Unit& u, int wr, int wc, int fr, int fq) const {
        const int row0 = u.pm * BM + wr * 64 + fr, col0 = u.pn * BM + wc * 32 + 8 * fq, kind = u.pn >> 2;
        row_scale_table(ss, RS, u.pm, (wr * 4 + wc) * 64 + fq * 16 + fr);
        f32x4 lbv[2][2];
        if (kind == 4) {
#pragma unroll
            for (int bj = 0; bj < 2; ++bj)
#pragma unroll
                for (int n = 0; n < 2; ++n) lbv[bj][n] = *(const f32x4*)(lbt + (col0 - 4096) + bj * HALF + 4 * n);
        }
#pragma unroll
        for (int ai = 0; ai < 2; ++ai) { float rs[4];
#pragma unroll
            for (int m = 0; m < 4; ++m) rs[m] = RS[4 + ai * HALF + wr * 64 + m * 16 + fr];
#pragma unroll
            for (int m = 0; m < 4; ++m) { bf16_t* rowp = O + (size_t)(row0 + ai * HALF + m * 16) * ldc + col0;
#pragma unroll
                for (int bj = 0; bj < 2; ++bj) { f32x4 v[2] = {acc[ai][bj][m][0] * rs[m], acc[ai][bj][m][1] * rs[m]};
                    if (kind == 3 || kind == 6) {
#pragma unroll
                        for (int n = 0; n < 2; ++n)
#pragma unroll
                            for (int j = 0; j < 4; ++j) v[n][j] = silu_f(v[n][j]);
                    } else if (kind == 4) {
#pragma unroll
                        for (int n = 0; n < 2; ++n)
#pragma unroll
                            for (int j = 0; j < 4; ++j) { const float z = v[n][j], t = __builtin_amdgcn_exp2f(-1.44269504089f * __builtin_fabsf(z)), ri = __builtin_amdgcn_rcpf(1.0f + t);
                                const float sig = z >= 0.f ? ri : t * ri, lb = lbv[bj][n][j]; v[n][j] = __builtin_amdgcn_logf(__builtin_fmaxf(lb + (1.0f - lb) * sig, 1e-30f)); }
                    }
                    u32x4 w; w.x = cvt_pk_bf16(v[0][0], v[0][1]); w.y = cvt_pk_bf16(v[0][2], v[0][3]); w.z = cvt_pk_bf16(v[1][0], v[1][1]); w.w = cvt_pk_bf16(v[1][2], v[1][3]);
                    ST16(rowp + bj * HALF, w); } } }
    }
};
struct EpiResBf16 {
    static constexpr bool PERM = true, AFTER_DRAIN = false; static constexpr int NST = 16;
    const bf16_t* res; bf16_t* out; int ldc; float* ss; PG8_LAS float* P;
    __device__ __forceinline__ void operator()(const f32x4 (&acc)[2][2][4][2], const Unit& u, int wr, int wc, int fr, int fq) const {
        const int row0 = u.pm * BM + wr * 64 + fr, col0 = u.pn * BM + wc * 32 + 8 * fq;
#pragma unroll
        for (int ai = 0; ai < 2; ++ai) {
            u32x4 r[4][2];
#pragma unroll
            for (int m = 0; m < 4; ++m)
#pragma unroll
                for (int bj = 0; bj < 2; ++bj) r[m][bj] = *(const u32x4*)(res + (size_t)(row0 + ai * HALF + m * 16) * ldc + col0 + bj * HALF);
            asm volatile("" ::: "memory");
#pragma unroll
            for (int m = 0; m < 4; ++m) { float s = 0.f;
#pragma unroll
                for (int bj = 0; bj < 2; ++bj) { const u32x4 q = r[m][bj]; const f32x4 a0 = acc[ai][bj][m][0], a1 = acc[ai][bj][m][1]; u32x4 w;
                    w.x = cvt_pk_bf16(__uint_as_float(q.x << 16) + a0[0], __uint_as_float(q.x & 0xffff0000u) + a0[1]); w.y = cvt_pk_bf16(__uint_as_float(q.y << 16) + a0[2], __uint_as_float(q.y & 0xffff0000u) + a0[3]);
                    w.z = cvt_pk_bf16(__uint_as_float(q.z << 16) + a1[0], __uint_as_float(q.z & 0xffff0000u) + a1[1]); w.w = cvt_pk_bf16(__uint_as_float(q.w << 16) + a1[2], __uint_as_float(q.w & 0xffff0000u) + a1[3]);
                    *(u32x4*)(out + (size_t)(row0 + ai * HALF + m * 16) * ldc + col0 + bj * HALF) = w;
#pragma unroll
                    for (int e = 0; e < 4; ++e) { const float lo = __uint_as_float(w[e] << 16), hi = __uint_as_float(w[e] & 0xffff0000u); s += lo * lo + hi * hi; } }
                s += __shfl_xor(s, 16); s += __shfl_xor(s, 32);
                if (fq == 0) P[(ai * HALF + wr * 64 + m * 16 + fr) * 4 + wc] = s; }
            asm volatile("" ::: "memory");
        }
        asm volatile("s_waitcnt lgkmcnt(0)" ::: "memory"); __builtin_amdgcn_s_barrier(); asm volatile("" ::: "memory");
        const int t = (wr * 4 + wc) * 64 + fq * 16 + fr;
        if (t < BM) { const f32x4 p = *(const PG8_LAS f32x4*)(P + t * 4); ss[(size_t)(u.pm * BM + t) * 8 + u.pn] = (p[0] + p[1]) + (p[2] + p[3]); }
    }
};
struct EpiSwiGLU {
    static constexpr bool PERM = true, AFTER_DRAIN = false; static constexpr int NST = 8;
    bf16_t* H; int ldh; const float* ss; PG8_LAS float* RS;
    __device__ __forceinline__ void operator()(const f32x4 (&acc)[2][2][4][2], const Unit& u, int wr, int wc, int fr, int fq) const {
        const int row0 = u.pm * BM + wr * 64 + fr, col0 = u.pn * HALF + wc * 32 + 8 * fq;
        row_scale_table(ss, RS, u.pm, (wr * 4 + wc) * 64 + fq * 16 + fr);
#pragma unroll
        for (int ai = 0; ai < 2; ++ai) { float rs[4];
#pragma unroll
            for (int m = 0; m < 4; ++m) rs[m] = RS[4 + ai * HALF + wr * 64 + m * 16 + fr];
#pragma unroll
            for (int m = 0; m < 4; ++m) { bf16_t* rowp = H + (size_t)(row0 + ai * HALF + m * 16) * ldh + col0;
                const f32x4 g0 = acc[ai][0][m][0] * rs[m], g1 = acc[ai][0][m][1] * rs[m], u0 = acc[ai][1][m][0] * rs[m], u1 = acc[ai][1][m][1] * rs[m];
                u32x4 w; w.x = cvt_pk_bf16(silu_f(g0[0]) * u0[0], silu_f(g0[1]) * u0[1]); w.y = cvt_pk_bf16(silu_f(g0[2]) * u0[2], silu_f(g0[3]) * u0[3]);
                w.z = cvt_pk_bf16(silu_f(g1[0]) * u1[0], silu_f(g1[1]) * u1[1]); w.w = cvt_pk_bf16(silu_f(g1[2]) * u1[2], silu_f(g1[3]) * u1[3]);
                ST16(rowp, w); } }
    }
};

template <class Epi, class Sched, bool ALIGN_EPI = false, bool SP2 = false>
__device__ __forceinline__ void gemm_phase(PG8_LAS unsigned char* lds, const Gemm g, const Sched& S, const Epi& E, unsigned long long& gp_acc) {
    unsigned long long gp_t0 = 0; (void)gp_t0; (void)gp_acc;
#define GP_B(k) do { if (TPROBE == (k)) gp_t0 = __builtin_amdgcn_s_memrealtime(); } while (0)
#define GP_E(k) do { if (TPROBE == (k)) gp_acc += __builtin_amdgcn_s_memrealtime() - gp_t0; } while (0)
    int tid_ = threadIdx.x; asm volatile("" : "+v"(tid_));
    const int tid = tid_, wid = __builtin_amdgcn_readfirstlane(tid >> 6), lane = tid & 63, wr = wid >> 2, wc = wid & 3, fr = lane & 15, fq = lane >> 4;
    const int K = g.K, nt = K / BK;
    unsigned voffA[2], voffB[2];
#pragma unroll
    for (int i = 0; i < 2; ++i) { int R, C; stage_rc(tid * 16 + i * 8192, R, C); const int Rb = Epi::PERM ? ((R & ~31) + perm32(R & 31)) : R;
        voffA[i] = (unsigned)(R * K + C) * 2u; voffB[i] = (unsigned)(Rb * K + C) * 2u; }
    const size_t kstep = (size_t)(BK * 2);
    const size_t hstep = (size_t)HALF * K * 2;
    const size_t tstep = 2 * hstep;
    const unsigned ldsw = (unsigned)wid * 1024u;
    const int aoff = lds_byte(wr * 64 + fr, fq * 8), boff = lds_byte(wc * 32 + fr, fq * 8);
#define PG8_SA(b, h) (((b) * 2 + (h)) * HTB)
#define PG8_SB(b, h) ((4 + (b) * 2 + (h)) * HTB)
#define PG8_STAGE(bufoff, gbase, voff) do { _Pragma("unroll") for (int _i = 0; _i < 2; ++_i) \
        __builtin_amdgcn_global_load_lds((const unsigned*)((const char*)(gbase) + (voff)[_i]), (PG8_LAS unsigned*)(lds + (bufoff) + ldsw + _i * 8192), 16, 0, 0); } while (0)
#define PG8_LDA(dst, b, h) do { _Pragma("unroll") for (int m = 0; m < 4; ++m) _Pragma("unroll") for (int k = 0; k < 2; ++k) dst[m][k] = *(const PG8_LAS bf16x8*)(lds + PG8_SA(b, h) + aoff + m * 2048 + k * 1024); } while (0)
#define PG8_LDB(dst, b, h) do { _Pragma("unroll") for (int n = 0; n < 2; ++n) _Pragma("unroll") for (int k = 0; k < 2; ++k) dst[n][k] = *(const PG8_LAS bf16x8*)(lds + PG8_SB(b, h) + boff + n * 2048 + k * 1024); } while (0)
#define PG8_MMA(ai, bj, At, Bt) do { __builtin_amdgcn_s_setprio(1); _Pragma("unroll") for (int m = 0; m < 4; ++m) _Pragma("unroll") for (int n = 0; n < 2; ++n) _Pragma("unroll") for (int k = 0; k < 2; ++k) \
        acc[ai][bj][m][n] = __builtin_amdgcn_mfma_f32_16x16x32_bf16(Bt[n][k], At[m][k], acc[ai][bj][m][n], 0, 0, 0); __builtin_amdgcn_s_setprio(0); } while (0)
#define PG8_WAIT_V(n) asm volatile("s_waitcnt vmcnt(" #n ")" ::: "memory")
#define PG8_WAIT_V8R do { if constexpr (Epi::NST == 16) asm volatile("s_waitcnt vmcnt(24)\n\ts_cmp_lg_u32 %0, 0\n\ts_cbranch_scc1 1f\n\ts_waitcnt vmcnt(8)\n1:" :: "s"(relax) : "memory", "scc"); \
        else if constexpr (Epi::NST == 8) asm volatile("s_waitcnt vmcnt(16)\n\ts_cmp_lg_u32 %0, 0\n\ts_cbranch_scc1 1f\n\ts_waitcnt vmcnt(8)\n1:" :: "s"(relax) : "memory", "scc"); \
        else asm volatile("s_waitcnt vmcnt(8)" ::: "memory"); } while (0)
#define PG8_WAIT_L(n) asm volatile("s_waitcnt lgkmcnt(" #n ")" ::: "memory")
#define PG8_BAR __builtin_amdgcn_s_barrier()
#define PG8_SCHED __builtin_amdgcn_sched_barrier(0)
    Unit cur, nxt; int ui = 0;
    if (!S.next(0, cur)) return;
    f32x4 acc[2][2][4][2];
#pragma unroll
    for (int a = 0; a < 2; ++a)
#pragma unroll
        for (int b = 0; b < 2; ++b)
#pragma unroll
            for (int m = 0; m < 4; ++m)
#pragma unroll
                for (int n = 0; n < 2; ++n) acc[a][b][m][n] = (f32x4){0.f, 0.f, 0.f, 0.f};
    bf16x8 At[4][2], B0[2][2], B1[2][2];
    const char* cA = (const char*)g.A + (size_t)cur.pm * tstep; const char* cB = (const char*)g.Bt + (size_t)cur.pn * tstep;
    S.a_ready(cur);
    if constexpr (SP2) {
        PG8_STAGE(PG8_SB(0, 0), cB, voffB); PG8_STAGE(PG8_SB(0, 1), cB + hstep, voffB); PG8_STAGE(PG8_SA(0, 0), cA, voffA); PG8_STAGE(PG8_SA(0, 1), cA + hstep, voffA);
        if (wr == 1) PG8_BAR;
        PG8_WAIT_V(2); PG8_BAR;
        PG8_STAGE(PG8_SB(1, 0), cB + kstep, voffB); PG8_STAGE(PG8_SA(1, 0), cA + kstep, voffA); PG8_STAGE(PG8_SB(1, 1), cB + hstep + kstep, voffB);
        PG8_WAIT_V(6); PG8_BAR;
    } else {
        PG8_STAGE(PG8_SB(0, 0), cB, voffB); PG8_STAGE(PG8_SA(0, 0), cA, voffA); PG8_STAGE(PG8_SB(0, 1), cB + hstep, voffB); PG8_STAGE(PG8_SA(0, 1), cA + hstep, voffA);
        if (wr == 1) PG8_BAR;
        PG8_WAIT_V(4); PG8_BAR;
        PG8_STAGE(PG8_SB(1, 0), cB + kstep, voffB); PG8_STAGE(PG8_SA(1, 0), cA + kstep, voffA); PG8_STAGE(PG8_SB(1, 1), cB + hstep + kstep, voffB);
        PG8_WAIT_V(6); PG8_BAR;
    }
    for (;;) {
        const bool has_next = S.next(ui + 1, nxt);
        const char* nA = has_next ? (const char*)g.A + (size_t)nxt.pm * tstep : cA; const char* nB = has_next ? (const char*)g.Bt + (size_t)nxt.pn * tstep : cB;
        for (int t = 0; t < nt; t += 2) {
            const bool last = (t == nt - 2); const int relax = __builtin_amdgcn_readfirstlane((RELAX_EPI && (t == 0) && (ui > 0)) ? 1 : 0);
            const char* a1 = cA + (size_t)(t + 1) * kstep;
            const char* a2 = last ? nA : cA + (size_t)(t + 2) * kstep; const char* b2 = last ? nB : cB + (size_t)(t + 2) * kstep;
            const char* a3 = a2 + kstep; const char* b3 = b2 + kstep;
            if (last && has_next) S.a_ready(nxt);
            if (t == 0) GP_B(21); GP_B(22);
            if constexpr (SP2) {
            PG8_LDB(B0, 0, 0); PG8_LDB(B1, 0, 1); PG8_SCHED; PG8_LDA(At, 0, 0); PG8_STAGE(PG8_SA(1, 1), a1 + hstep, voffA);
            PG8_WAIT_V8R; PG8_WAIT_L(0); PG8_BAR; PG8_MMA(0, 0, At, B0); PG8_MMA(0, 1, At, B1); PG8_BAR; PG8_SCHED;
            PG8_LDA(At, 0, 1); PG8_STAGE(PG8_SB(0, 0), b2, voffB); PG8_STAGE(PG8_SB(0, 1), b2 + hstep, voffB); PG8_STAGE(PG8_SA(0, 0), a2, voffA);
            PG8_WAIT_V8R; PG8_WAIT_L(0); PG8_BAR; PG8_MMA(1, 0, At, B0); PG8_MMA(1, 1, At, B1); PG8_BAR; PG8_SCHED;
            PG8_LDB(B0, 1, 0); PG8_LDB(B1, 1, 1); PG8_SCHED; PG8_LDA(At, 1, 0); PG8_STAGE(PG8_SA(0, 1), a2 + hstep, voffA);
            PG8_WAIT_V(8); PG8_WAIT_L(0); PG8_BAR; PG8_MMA(0, 0, At, B0); PG8_MMA(0, 1, At, B1); PG8_BAR; PG8_SCHED;
            PG8_LDA(At, 1, 1); PG8_STAGE(PG8_SB(1, 0), b3, voffB); PG8_STAGE(PG8_SB(1, 1), b3 + hstep, voffB); PG8_STAGE(PG8_SA(1, 0), a3, voffA);
            PG8_WAIT_V(8); PG8_WAIT_L(0); PG8_BAR; PG8_MMA(1, 0, At, B0); PG8_MMA(1, 1, At, B1); PG8_BAR; PG8_SCHED;
            } else {
            PG8_LDB(B0, 0, 0); PG8_SCHED; PG8_LDA(At, 0, 0); PG8_STAGE(PG8_SA(1, 1), a1 + hstep, voffA);
            PG8_WAIT_L(8); PG8_BAR; PG8_WAIT_L(0); PG8_MMA(0, 0, At, B0); PG8_BAR; PG8_SCHED;
            PG8_LDB(B1, 0, 1); PG8_STAGE(PG8_SB(0, 0), b2, voffB);
            PG8_BAR; PG8_WAIT_L(0); PG8_MMA(0, 1, At, B1); PG8_BAR;
            PG8_LDA(At, 0, 1); PG8_STAGE(PG8_SA(0, 0), a2, voffA);
            PG8_BAR; PG8_WAIT_L(0); PG8_MMA(1, 0, At, B0); PG8_BAR; PG8_SCHED;
            PG8_STAGE(PG8_SB(0, 1), b2 + hstep, voffB);
            PG8_WAIT_V(6); PG8_BAR; PG8_MMA(1, 1, At, B1); PG8_BAR;
            PG8_LDB(B0, 1, 0); PG8_SCHED; PG8_LDA(At, 1, 0); PG8_STAGE(PG8_SA(0, 1), a2 + hstep, voffA);
            PG8_WAIT_L(8); PG8_BAR; PG8_WAIT_L(0); PG8_MMA(0, 0, At, B0); PG8_BAR; PG8_SCHED;
            PG8_LDB(B1, 1, 1); PG8_STAGE(PG8_SB(1, 0), b3, voffB);
            PG8_BAR; PG8_WAIT_L(0); PG8_MMA(0, 1, At, B1); PG8_BAR;
            PG8_LDA(At, 1, 1); PG8_STAGE(PG8_SA(1, 0), a3, voffA);
            PG8_BAR; PG8_WAIT_L(0); PG8_MMA(1, 0, At, B0); PG8_BAR; PG8_SCHED;
            PG8_STAGE(PG8_SB(1, 1), b3 + hstep, voffB);
            PG8_WAIT_V(6); PG8_BAR; PG8_MMA(1, 1, At, B1); PG8_BAR;
            }
            if (t == 0) GP_E(21); GP_E(22);
        }
        if constexpr (ALIGN_EPI) { if (wr == 0) PG8_BAR; }
        GP_B(20);
        if constexpr (!Epi::AFTER_DRAIN) { E(acc, cur, wr, wc, fr, fq);
#if defined(DUP_EPI) && DUP_EPI
            if constexpr (Epi::PERM) { asm volatile("" ::: "memory"); E(acc, cur, wr, wc, fr, fq); }
#endif
            S.done(cur); }
        GP_E(20);
        if (!has_next) break;
#pragma unroll
        for (int a = 0; a < 2; ++a)
#pragma unroll
            for (int b = 0; b < 2; ++b)
#pragma unroll
                for (int m = 0; m < 4; ++m)
#pragma unroll
                    for (int n = 0; n < 2; ++n) acc[a][b][m][n] = (f32x4){0.f, 0.f, 0.f, 0.f};
        cur = nxt; cA = nA; cB = nB; ++ui;
        if constexpr (ALIGN_EPI) { if (wr == 1) PG8_BAR; }
    }
    PG8_WAIT_V(0);
    if constexpr (!ALIGN_EPI) { if (wr == 0) PG8_BAR; }
    PG8_BAR;
    if constexpr (Epi::AFTER_DRAIN) { E.fused(acc, cur, wr, wc, fr, fq, lds, wid, lane); S.done(cur); }
#undef PG8_SA
#undef PG8_SB
#undef PG8_STAGE
#undef PG8_LDA
#undef PG8_LDB
#undef PG8_MMA
#undef PG8_WAIT_V
#undef PG8_WAIT_V8R
#undef PG8_WAIT_L
#undef PG8_BAR
#undef PG8_SCHED
#undef GP_B
#undef GP_E
}
}

constexpr int NWAVES = 8, NTHR = 512;
constexpr int D = 2048, BATCH = 16, SEQ = 2048, M = BATCH * SEQ, DEPTH = 4;
constexpr int DC = 1024, DH = 1024, DIN = 7168, DFF = 5632, NGU = 2 * DFF, HEADS = 8, HD = 128;
constexpr int C_B = 0, C_C = 1024, C_H = 2048, C_Q = 3072, C_Z = 4096, C_I = 5120, C_G = 6144;
constexpr float EPS = 1e-6f;
#ifndef MK_ONE_LAUNCH
#define MK_ONE_LAUNCH 1
#endif
constexpr int NPH = 2 + 5 * DEPTH;

constexpr size_t MiB = 1u << 20;
constexpr size_t WS_CTL = 0, CTL_ZERO_BYTES = 1 * MiB;
constexpr size_t WS_LB = 1 * MiB;
constexpr size_t WS_SS = 2 * MiB;
constexpr size_t WS_WIN = 3 * MiB, SZ_WIN = (size_t)DIN * D * 2;
constexpr size_t WS_WOUT = WS_WIN + DEPTH * SZ_WIN, SZ_WOUT = (size_t)D * D * 2;
constexpr size_t WS_WGU = WS_WOUT + DEPTH * SZ_WOUT, SZ_WGU = (size_t)NGU * D * 2;
constexpr size_t WS_WDN = WS_WGU + DEPTH * SZ_WGU, SZ_WDN = (size_t)D * DFF * 2;
constexpr size_t WS_HB = WS_WDN + DEPTH * SZ_WDN;
constexpr size_t WS_PROJ = WS_HB + (size_t)M * D * 2;
constexpr size_t WS_END = WS_PROJ + (size_t)M * DIN * 2;
constexpr int CW_BAR = 4096;

constexpr int RING_OFF = 0, RING_BYTES = 131072;
constexpr int MISC_OFF = RING_BYTES + 320;
constexpr int RST_OFF = RING_BYTES + 8192;
constexpr int PSS_OFF = RING_BYTES + 1024;
constexpr int LDS_BYTES = 147456;

#define GAS __attribute__((address_space(1)))
#define LAS __attribute__((address_space(3)))
typedef unsigned short bf16;
typedef unsigned v4u __attribute__((ext_vector_type(4)));
typedef unsigned v2u __attribute__((ext_vector_type(2)));
typedef float f32x4 __attribute__((ext_vector_type(4)));
#define LDS_WAIT() asm volatile("s_waitcnt lgkmcnt(0)" ::: "memory")
#define VM_WAIT() asm volatile("s_waitcnt vmcnt(0)" ::: "memory")
__device__ __forceinline__ unsigned pk2(float lo, float hi) { return pg8::cvt_pk_bf16(lo, hi); }
__device__ __forceinline__ float bf_lo(unsigned w) { return __uint_as_float(w << 16); }
__device__ __forceinline__ float bf_hi(unsigned w) { return __uint_as_float(w & 0xffff0000u); }
__device__ __forceinline__ void unpack8(const v4u r, float (&o)[8]) { o[0] = bf_lo(r.x); o[1] = bf_hi(r.x); o[2] = bf_lo(r.y); o[3] = bf_hi(r.y); o[4] = bf_lo(r.z); o[5] = bf_hi(r.z); o[6] = bf_lo(r.w); o[7] = bf_hi(r.w); }
__device__ __forceinline__ v4u pack8(const float (&o)[8]) { v4u w; w.x = pk2(o[0], o[1]); w.y = pk2(o[2], o[3]); w.z = pk2(o[4], o[5]); w.w = pk2(o[6], o[7]); return w; }
__device__ __forceinline__ float wave_sum(float v) {
#pragma unroll
    for (int o = 1; o < 64; o <<= 1) v += __shfl_xor(v, o);
    return v;
}
__device__ __forceinline__ float sum16(float v) {
#pragma unroll
    for (int o = 1; o < 16; o <<= 1) v += __shfl_xor(v, o);
    return v;
}
#define XB_TMO      128
#define XB_XCNT(j)  (256  + 64 * (j))
#define XB_XSUB(j)  (1280 + 64 * (j))
#define XB_XGEN(j)  (2304 + 64 * (j))
#define XB_TOP      3328
#define XB_TOPGEN   3392
#define XCD_BAR_WORDS 3456
#define XB_SPIN_CAP (1u << 18)

__device__ __forceinline__ unsigned xb_ld(unsigned* p)              { return __hip_atomic_load(p, __ATOMIC_RELAXED, __HIP_MEMORY_SCOPE_AGENT); }
__device__ __forceinline__ unsigned xb_add(unsigned* p, unsigned v) { return __hip_atomic_fetch_add(p, v, __ATOMIC_RELAXED, __HIP_MEMORY_SCOPE_AGENT); }
__device__ __forceinline__ unsigned xb_xcc_id() { return (unsigned)__builtin_amdgcn_s_getreg((3 << 11) | 20) & 0xFu; }
#define XB_SPIN(cond, bar) do { unsigned _sp = 0; while (cond) { __builtin_amdgcn_s_sleep(1); \
    if ((++_sp & 255u) == 0u) { if (xb_ld(&(bar)[XB_TMO])) break; if (_sp > XB_SPIN_CAP) { atomicAdd(&(bar)[XB_TMO], 1u); break; } } } } while (0)

struct XcdBarrier {
    unsigned* bar; unsigned x;
    volatile LAS unsigned* st;
};

__device__ __forceinline__ XcdBarrier xcd_barrier_post(unsigned* bar, volatile LAS unsigned* st) {
    XcdBarrier b; b.bar = bar; b.x = xb_xcc_id(); b.st = st;
    if (threadIdx.x == 0) (void)xb_add(&bar[XB_XCNT(b.x)], 1u);
    return b;
}
__device__ __forceinline__ void xcd_barrier_complete(unsigned* bar, unsigned x, unsigned& nloc, unsigned& nx) {
    const unsigned G = gridDim.x * gridDim.y * gridDim.z;
    unsigned sum, cnt, mine, sp = 0u;
    for (;;) {
        sum = 0u; cnt = 0u; mine = 0u;
#pragma unroll
        for (unsigned j = 0; j < 16; ++j) { const unsigned c = xb_ld(&bar[XB_XCNT(j)]); sum += c; cnt += (c > 0u) ? 1u : 0u; mine = (j == x) ? c : mine; }
        if (sum == G) break;
        __builtin_amdgcn_s_sleep(1);
        if ((++sp & 255u) == 0u) { if (xb_ld(&bar[XB_TMO])) break; if (sp > XB_SPIN_CAP) { atomicAdd(&bar[XB_TMO], 1u); break; } }
    }
    nloc = mine > 0u ? mine : 1u; nx = cnt > 0u ? cnt : 1u;
}

__device__ __forceinline__ void xcd_barrier(const XcdBarrier& b) {
    asm volatile("s_waitcnt vmcnt(0)" ::: "memory");
    __syncthreads();
    if (threadIdx.x == 0) {
        unsigned* bar = b.bar;
        __builtin_amdgcn_s_waitcnt(0);
        unsigned nloc = b.st[0], nx = b.st[1];
        if (nloc == 0u) { xcd_barrier_complete(bar, b.x, nloc, nx); b.st[0] = nloc; b.st[1] = nx; }
        const unsigned old = xb_add(&bar[XB_XSUB(b.x)], 1u);
        const unsigned gen = old / nloc;
        if (old + 1u == (gen + 1u) * nloc) {
            __builtin_amdgcn_fence(__ATOMIC_RELEASE, "agent");
            asm volatile("s_waitcnt vmcnt(0)" ::: "memory");
            const unsigned og = xb_add(&bar[XB_TOP], 1u);
            const unsigned tg = og / nx;
            if (og + 1u == (tg + 1u) * nx) xb_add(&bar[XB_TOPGEN], 1u);
            else XB_SPIN(xb_ld(&bar[XB_TOPGEN]) == tg, bar);
            __builtin_amdgcn_fence(__ATOMIC_ACQUIRE, "agent");
            xb_add(&bar[XB_XGEN(b.x)], 1u);
            asm volatile("s_waitcnt vmcnt(0)" ::: "memory");
        } else {
            XB_SPIN(xb_ld(&bar[XB_XGEN(b.x)]) == gen, bar);
            __builtin_amdgcn_fence(__ATOMIC_ACQUIRE, "agent");
            asm volatile("s_waitcnt vmcnt(0)" ::: "memory");
        }
    }
    __syncthreads();
}

__device__ __forceinline__ void transpose_item(const float* W, int K, int N, bf16* WT, int k0, int n0, int drow0, LAS float* scr, int lane, const float* gain) {
#pragma unroll 8
    for (int i = 0; i < 32; ++i) { const int kk = 2 * i + (lane >> 5); const float gk = gain ? gain[k0 + kk] : 1.0f; scr[kk * 33 + (lane & 31)] = W[(size_t)(k0 + kk) * N + n0 + (lane & 31)] * gk; }
    LDS_WAIT(); asm volatile("" ::: "memory");
    const int c = lane & 7;
#pragma unroll
    for (int j = 0; j < 4; ++j) { const int n = (lane >> 3) + 8 * j; const LAS float* s = scr + (8 * c) * 33 + n;
        v4u o; o.x = pk2(s[0 * 33], s[1 * 33]); o.y = pk2(s[2 * 33], s[3 * 33]); o.z = pk2(s[4 * 33], s[5 * 33]); o.w = pk2(s[6 * 33], s[7 * 33]);
        *(v4u*)(WT + (size_t)(drow0 + n) * K + k0 + 8 * c) = o; }
    LDS_WAIT(); asm volatile("" ::: "memory");
}
__device__ __forceinline__ void weights_phase(const float* w_in, const float* w_out, const float* w_gate, const float* w_up, const float* w_down, const float* norm_mix, const float* norm_ffn,
                                              unsigned char* ws, LAS unsigned char* lds, int l0, int l1, int gw, int NGW, int wave, int lane) {
    LAS float* scr = (LAS float*)(lds + RING_OFF + wave * 16384);
    constexpr int I_IN = (D / 64) * (DIN / 32), I_OUT = (D / 64) * (D / 32), I_G = (D / 64) * (DFF / 32), I_DN = (DFF / 64) * (D / 32);
    constexpr int PER_LAYER = I_IN + I_OUT + 2 * I_G + I_DN;
    for (int it = l0 * PER_LAYER + gw; it < l1 * PER_LAYER; it += NGW) {
        const int l = it / PER_LAYER; int r = it % PER_LAYER;
        if (r < I_IN) { const int nb = r % (DIN / 32), kb = r / (DIN / 32);
            transpose_item(w_in + (size_t)l * D * DIN, D, DIN, (bf16*)(ws + WS_WIN + l * SZ_WIN), kb * 64, nb * 32, nb * 32, scr, lane, norm_mix + l * D); continue; } r -= I_IN;
        if (r < I_OUT) { const int nb = r % (D / 32), kb = r / (D / 32);
            transpose_item(w_out + (size_t)l * D * D, D, D, (bf16*)(ws + WS_WOUT + l * SZ_WOUT), kb * 64, nb * 32, nb * 32, scr, lane, nullptr); continue; } r -= I_OUT;
        if (r < I_G) { const int nb = r % (DFF / 32), kb = r / (DFF / 32), n0 = nb * 32;
            transpose_item(w_gate + (size_t)l * D * DFF, D, DFF, (bf16*)(ws + WS_WGU + l * SZ_WGU), kb * 64, n0, (n0 >> 7) * 256 + (n0 & 127), scr, lane, norm_ffn + l * D); continue; } r -= I_G;
        if (r < I_G) { const int nb = r % (DFF / 32), kb = r / (DFF / 32), n0 = nb * 32;
            transpose_item(w_up + (size_t)l * D * DFF, D, DFF, (bf16*)(ws + WS_WGU + l * SZ_WGU), kb * 64, n0, (n0 >> 7) * 256 + 128 + (n0 & 127), scr, lane, norm_ffn + l * D); continue; } r -= I_G;
        { const int nb = r % (D / 32), kb = r / (D / 32);
            transpose_item(w_down + (size_t)l * DFF * D, DFF, D, (bf16*)(ws + WS_WDN + l * SZ_WDN), kb * 64, nb * 32, nb * 32, scr, lane, nullptr); }
    }
}
__device__ __forceinline__ void xconv_phase(const float* x_in, bf16* xb, float* ss, const float* lb_logits, float* lbt, int gw, int NGW, int lane, int gtid) {
    for (int m = gw; m < M; m += NGW) {
        const f32x4* xr = (const f32x4*)(x_in + (size_t)m * D) + lane; v2u* o = (v2u*)(xb + (size_t)m * D) + lane; float s = 0.f;
#pragma unroll
        for (int j = 0; j < 8; ++j) { const f32x4 v = xr[64 * j]; v2u w; w.x = pk2(v.x, v.y); w.y = pk2(v.z, v.w); o[64 * j] = w;
            const float a = bf_lo(w.x), b = bf_hi(w.x), c = bf_lo(w.y), d = bf_hi(w.y); s += (a * a + b * b) + (c * c + d * d); }
        s = wave_sum(s);
        if (lane < 8) ss[(size_t)m * 8 + lane] = lane == 0 ? s : 0.f;
    }
    if (gtid < DH) {
        float lg[DEPTH], mx = -3.0e38f;
#pragma unroll
        for (int l = 0; l < DEPTH; ++l) { lg[l] = lb_logits[l * DH + gtid]; mx = fmaxf(mx, lg[l]); }
        float den = 0.f;
#pragma unroll
        for (int l = 0; l < DEPTH; ++l) { lg[l] = __expf(lg[l] - mx); den += lg[l]; }
        float cum = 0.f; const float p0 = lg[0] / den;
#pragma unroll
        for (int l = 0; l < DEPTH; ++l) { cum += lg[l] / den; lbt[l * DH + gtid] = fminf(fmaxf(cum - p0, 0.f), 1.0f - 1e-4f); }
    }
}
__device__ __forceinline__ void final_norm_phase(const bf16* x, const float* gain, float* out, int gw, int NGW, int lane) {
    f32x4 g[8];
#pragma unroll
    for (int j = 0; j < 8; ++j) g[j] = ((const f32x4*)gain)[lane + 64 * j];
    for (int m = gw; m < M; m += NGW) {
        const v2u* xr = (const v2u*)(x + (size_t)m * D) + lane;
        f32x4 v[8]; float s = 0.f;
#pragma unroll
        for (int j = 0; j < 8; ++j) { const v2u w = xr[64 * j]; v[j] = (f32x4){bf_lo(w.x), bf_hi(w.x), bf_lo(w.y), bf_hi(w.y)}; s += (v[j].x * v[j].x + v[j].y * v[j].y) + (v[j].z * v[j].z + v[j].w * v[j].w); }
        const float rs = 1.0f / sqrtf(wave_sum(s) * (1.0f / D) + EPS);
        f32x4* o = (f32x4*)(out + (size_t)m * D) + lane;
#pragma unroll
        for (int j = 0; j < 8; ++j) o[64 * j] = v[j] * rs * g[j];
    }
}
__device__ __forceinline__ void conv_phase(const bf16* proj, const float* cw, const float* gn, bf16* mixed, int gw, int NGW, int lane) {
    constexpr int R = 16, NSTRIP = M / R;
    float w0[2][8], w1[2][8], w2[2][8], gg[2][8];
#pragma unroll
    for (int i = 0; i < 2; ++i)
#pragma unroll
        for (int e = 0; e < 8; ++e) { const int c = i * 512 + lane * 8 + e; w0[i][e] = cw[c]; w1[i][e] = cw[DC + c]; w2[i][e] = cw[2 * DC + c]; gg[i][e] = gn[c]; }
    for (int strip = gw; strip < NSTRIP; strip += NGW) {
        const int m0 = strip * R, t0 = m0 % SEQ;
        float u1[2][8], u2[2][8];
#pragma unroll
        for (int i = 0; i < 2; ++i) {
            if (t0 == 0) {
#pragma unroll
                for (int e = 0; e < 8; ++e) { u1[i][e] = 0.f; u2[i][e] = 0.f; }
            } else {
                const bf16* p1 = proj + (size_t)(m0 - 1) * DIN + i * 512 + lane * 8; const bf16* p2 = p1 - DIN;
                float c1[8], h1[8], c2[8], h2[8];
                unpack8(*(const v4u*)(p1 + C_C), c1); unpack8(*(const v4u*)(p1 + C_H), h1); unpack8(*(const v4u*)(p2 + C_C), c2); unpack8(*(const v4u*)(p2 + C_H), h2);
#pragma unroll
                for (int e = 0; e < 8; ++e) { u1[i][e] = c1[e] * h1[e]; u2[i][e] = c2[e] * h2[e]; }
            }
        }
        for (int r = 0; r < R; ++r) {
            const size_t m = (size_t)(m0 + r);
#pragma unroll
            for (int i = 0; i < 2; ++i) {
                const bf16* p = proj + m * DIN + i * 512 + lane * 8;
                float bb[8], cc[8], hh[8], y[8]; unpack8(*(const v4u*)(p + C_B), bb); unpack8(*(const v4u*)(p + C_C), cc); unpack8(*(const v4u*)(p + C_H), hh);
                float ss = 0.f;
#pragma unroll
                for (int e = 0; e < 8; ++e) { const float u0 = cc[e] * hh[e]; y[e] = bb[e] * (w0[i][e] * u2[i][e] + w1[i][e] * u1[i][e] + w2[i][e] * u0); ss += y[e] * y[e]; u2[i][e] = u1[i][e]; u1[i][e] = u0; }
                const float rs = 1.0f / sqrtf(sum16(ss) * (1.0f / 128.0f) + EPS);
#pragma unroll
                for (int e = 0; e < 8; ++e) y[e] = y[e] * rs * gg[i][e];
                *(v4u*)(mixed + m * D + i * 512 + lane * 8) = pack8(y);
            }
        }
    }
}
__device__ __forceinline__ void hgrn_fin_phase(const bf16* proj, const float* gn, bf16* mixed, int gw, int NGW, int lane) {
    float gg[2][8];
#pragma unroll
    for (int i = 0; i < 2; ++i)
#pragma unroll
        for (int e = 0; e < 8; ++e) gg[i][e] = gn[i * 512 + lane * 8 + e];
    for (int m = gw; m < M; m += NGW) {
#pragma unroll
        for (int i = 0; i < 2; ++i) {
            bf16* po = mixed + (size_t)m * D + DC + i * 512 + lane * 8;
            float o[8], g[8]; unpack8(*(const v4u*)po, o); unpack8(*(const v4u*)(proj + (size_t)m * DIN + C_G + i * 512 + lane * 8), g);
            float ss = 0.f;
#pragma unroll
            for (int e = 0; e < 8; ++e) ss += o[e] * o[e];
            const float rs = 1.0f / sqrtf(sum16(ss) * (1.0f / 128.0f) + EPS);
#pragma unroll
            for (int e = 0; e < 8; ++e) o[e] = o[e] * rs * gg[i][e] * g[e];
            *(v4u*)po = pack8(o);
        }
    }
}

typedef short bf16x8_t __attribute__((ext_vector_type(8)));
typedef short s16x4_t __attribute__((ext_vector_type(4)));
typedef short v4i16_t __attribute__((ext_vector_type(4)));
typedef float f32x16 __attribute__((ext_vector_type(16)));
typedef float f32x2_t __attribute__((ext_vector_type(2)));
typedef __bf16 bf16x2_t __attribute__((ext_vector_type(2)));
__device__ __forceinline__ unsigned cvtpk(float lo, float hi) { f32x2_t v = {lo, hi}; bf16x2_t b = __builtin_convertvector(v, bf16x2_t); return __builtin_bit_cast(unsigned, b); }
__device__ __forceinline__ s16x4_t tr_read(const LAS unsigned char* p) { return __builtin_bit_cast(s16x4_t, __builtin_amdgcn_ds_read_tr16_b64_v4i16((LAS v4i16_t*)p)); }
__device__ __forceinline__ constexpr int crow_c(int i, int h) { return (i & 3) + 8 * (i >> 2) + 4 * h; }
#define HG_BAR() do { asm volatile("s_waitcnt lgkmcnt(0)" ::: "memory"); __builtin_amdgcn_s_barrier(); asm volatile("" ::: "memory"); } while (0)
#define MFMA32(a, b, c) __builtin_amdgcn_mfma_f32_32x32x16_bf16((a), (b), (c), 0, 0, 0)
constexpr int HG_RS = 272, HG_TS = 80, HG_VS = 320;
constexpr int HP_QD = 0, HP_K0 = HP_QD + 32 * HG_RS, HP_K0T = HP_K0 + 32 * HG_RS, HP_VN = HP_K0T + 128 * HG_TS, HP_D = HP_VN + 32 * HG_VS, HP_SET = HP_D + 512;
constexpr int HP_TOT = 2 * HP_SET, HP_NRM = HP_TOT + 2 * 4 * 128 * 4, HP_RAW = HP_NRM + 2 * 512, HP_RAWB = 4 * 6144, HP_END = HP_RAW + 2 * HP_RAWB;
static_assert(HP_END <= RING_BYTES && (HP_RAW % 1024) == 0 && (HP_SET % 16) == 0 && (HP_K0T % 16) == 0 && (HP_VN % 16) == 0 && (HP_D % 16) == 0, "HGRN LDS map");
__device__ __forceinline__ bf16x8_t pack_step(const f32x16& x, int s) {
    v4u p; p.x = cvtpk(x[8 * s], x[8 * s + 1]); p.y = cvtpk(x[8 * s + 2], x[8 * s + 3]); p.z = cvtpk(x[8 * s + 4], x[8 * s + 5]); p.w = cvtpk(x[8 * s + 6], x[8 * s + 7]);
    return __builtin_bit_cast(bf16x8_t, p);
}
__device__ __forceinline__ void hg_tr8(const LAS unsigned char* pvt, const LAS unsigned char* pvn, bf16x8_t (&va)[2], bf16x8_t (&vb)[2]) {
    s16x4_t a0, a1, a2, a3, b0, b1, b2, b3;
    asm volatile("ds_read_b64_tr_b16 %0, %8\n\tds_read_b64_tr_b16 %1, %8 offset:%c10\n\tds_read_b64_tr_b16 %2, %8 offset:%c11\n\tds_read_b64_tr_b16 %3, %8 offset:%c12\n\t"
                 "ds_read_b64_tr_b16 %4, %9\n\tds_read_b64_tr_b16 %5, %9 offset:%c13\n\tds_read_b64_tr_b16 %6, %9 offset:%c11\n\tds_read_b64_tr_b16 %7, %9 offset:%c14\n\ts_waitcnt lgkmcnt(0)"
                 : "=&v"(a0), "=&v"(a1), "=&v"(a2), "=&v"(a3), "=&v"(b0), "=&v"(b1), "=&v"(b2), "=&v"(b3)
                 : "v"((unsigned)(size_t)pvt), "v"((unsigned)(size_t)pvn), "i"(8 * HG_VS), "i"(16 * HG_VS), "i"(24 * HG_VS), "i"(4 * HG_VS), "i"(20 * HG_VS) : "memory");
    va[0] = __builtin_shufflevector(a0, a1, 0, 1, 2, 3, 4, 5, 6, 7); va[1] = __builtin_shufflevector(a2, a3, 0, 1, 2, 3, 4, 5, 6, 7);
    vb[0] = __builtin_shufflevector(b0, b1, 0, 1, 2, 3, 4, 5, 6, 7); vb[1] = __builtin_shufflevector(b2, b3, 0, 1, 2, 3, 4, 5, 6, 7);
}
__device__ __forceinline__ void hg_dma_chunk(const bf16* pz, const bf16* pq, const bf16* pv, size_t on, LAS unsigned char* rawb) {
#pragma unroll
    for (int hh = 0; hh < 2; ++hh) {
        __builtin_amdgcn_global_load_lds((const unsigned*)(pz + on + (size_t)(4 * hh) * DIN), (LAS unsigned*)(rawb + 0 * 2048 + hh * 1024), 16, 0, 0);
        __builtin_amdgcn_global_load_lds((const unsigned*)(pq + on + (size_t)(4 * hh) * DIN), (LAS unsigned*)(rawb + 1 * 2048 + hh * 1024), 16, 0, 0);
        __builtin_amdgcn_global_load_lds((const unsigned*)(pv + on + (size_t)(4 * hh) * DIN), (LAS unsigned*)(rawb + 2 * 2048 + hh * 1024), 16, 0, 0);
    }
}
__device__ __forceinline__ void hg_E1(int cn, float (&bl)[8][2], float (&kk)[8][2], float (&qs)[8][2], unsigned (&vcur)[8], const bf16* pz, const bf16* pq, const bf16* pv, LAS unsigned char* lds, int ew, int lane) {
    constexpr int NCH = SEQ / 32;
    LAS unsigned char* rawb = lds + HP_RAW + (cn & 1) * HP_RAWB + ew * 6144;
    asm volatile("s_waitcnt vmcnt(6)" ::: "memory");
    unsigned rz[8], rq[8];
#pragma unroll
    for (int i = 0; i < 8; ++i) { rz[i] = *(const LAS unsigned*)(rawb + 0 * 2048 + i * 256 + 4 * lane); rq[i] = *(const LAS unsigned*)(rawb + 1 * 2048 + i * 256 + 4 * lane); vcur[i] = *(const LAS unsigned*)(rawb + 2 * 2048 + i * 256 + 4 * lane); }
    asm volatile("s_waitcnt lgkmcnt(0)" : "+v"(rz[0]), "+v"(rz[7]), "+v"(rq[0]), "+v"(rq[7]), "+v"(vcur[0]), "+v"(vcur[7]) :: "memory");
    hg_dma_chunk(pz, pq, pv, (size_t)(cn + 2 < NCH ? cn + 2 : cn) * 32 * DIN, rawb);
#pragma unroll
    for (int i = 0; i < 8; ++i) {
#pragma unroll
        for (int e = 0; e < 2; ++e) { const float l2 = e ? bf_hi(rz[i]) : bf_lo(rz[i]); qs[i][e] = e ? bf_hi(rq[i]) : bf_lo(rq[i]);
            kk[i][e] = 1.0f - __builtin_amdgcn_exp2f(l2); bl[i][e] = (i == 0) ? l2 : bl[i - 1][e] + l2; } }
    *(LAS f32x2_t*)(lds + HP_TOT + (cn & 1) * 2048 + (ew * 128 + 2 * lane) * 4) = (f32x2_t){bl[7][0], bl[7][1]};
}
__device__ __forceinline__ void hg_E2(int cn, const float (&bl)[8][2], const float (&kk)[8][2], const float (&qs)[8][2], const unsigned (&vcur)[8], LAS unsigned char* lds, int ew, int lane) {
    const int so = (cn & 1) * HP_SET;
    float off[2] = {0.f, 0.f}, b31[2] = {0.f, 0.f};
#pragma unroll
    for (int w = 0; w < 4; ++w) { const f32x2_t tw = *(const LAS f32x2_t*)(lds + HP_TOT + (cn & 1) * 2048 + (w * 128 + 2 * lane) * 4); if (w < ew) { off[0] += tw.x; off[1] += tw.y; } b31[0] += tw.x; b31[1] += tw.y; }
    unsigned kt0[4], kt1[4];
#pragma unroll
    for (int i = 0; i < 8; ++i) { const int t = 8 * ew + i; float qd[2], k0[2];
#pragma unroll
        for (int e = 0; e < 2; ++e) { const float bt = off[e] + bl[i][e]; qd[e] = qs[i][e] * __builtin_amdgcn_exp2f(bt); k0[e] = kk[i][e] * __builtin_amdgcn_exp2f(fminf(-bt, 115.0f)); }
        *(LAS unsigned*)(lds + so + HP_QD + t * HG_RS + 4 * lane) = cvtpk(qd[0], qd[1]);
        const unsigned kp = cvtpk(k0[0], k0[1]); *(LAS unsigned*)(lds + so + HP_K0 + t * HG_RS + 4 * lane) = kp;
        if ((i & 1) == 0) { kt0[i >> 1] = kp & 0xffffu; kt1[i >> 1] = kp >> 16; } else { kt0[i >> 1] |= kp << 16; kt1[i >> 1] |= kp & 0xffff0000u; }
        *(LAS unsigned*)(lds + so + HP_VN + t * HG_VS + 4 * lane) = vcur[i]; }
    *(LAS v4u*)(lds + so + HP_K0T + (2 * lane) * HG_TS + 16 * ew) = (v4u){kt0[0], kt0[1], kt0[2], kt0[3]};
    *(LAS v4u*)(lds + so + HP_K0T + (2 * lane + 1) * HG_TS + 16 * ew) = (v4u){kt1[0], kt1[1], kt1[2], kt1[3]};
    if (ew == 0) *(LAS f32x2_t*)(lds + so + HP_D + 8 * lane) = (f32x2_t){__builtin_amdgcn_exp2f(b31[0]), __builtin_amdgcn_exp2f(b31[1])};
}
__device__ __forceinline__ void hgrn_chunk_phase(const bf16* proj, const float* gn, bf16* mixed, int nitems, int item0, int istride, LAS unsigned char* lds, int tid, int wave, int lane, unsigned long long& tpa) {
    constexpr int NCH = SEQ / 32; unsigned long long t0_ = 0; (void)t0_;
    const int r = lane & 31, h = lane >> 5, q4 = (lane & 15) >> 2, p4 = lane & 3, g16 = (lane >> 4) & 1;
    for (int item = item0; item < nitems; item += istride) {
        const int b = item >> 3, hd = item & 7;
        if (wave >= 4) {
            const int ew = wave & 3;
            const bf16* pz = proj + (size_t)(b * SEQ + 8 * ew + (lane >> 4)) * DIN + C_Z + hd * HD + 8 * (lane & 15);
            const bf16* pq = proj + (size_t)(b * SEQ + 8 * ew + (lane >> 4)) * DIN + C_Q + hd * HD + 8 * (lane & 15);
            const bf16* pv = proj + (size_t)(b * SEQ + 8 * ew + (lane >> 4)) * DIN + C_I + hd * HD + 8 * (lane & 15);
            asm volatile("s_waitcnt vmcnt(0)" ::: "memory");
            hg_dma_chunk(pz, pq, pv, 0, lds + HP_RAW + ew * 6144);
            hg_dma_chunk(pz, pq, pv, (size_t)32 * DIN, lds + HP_RAW + HP_RAWB + ew * 6144);
            float bl[8][2], kk[8][2], qs[8][2]; unsigned vcur[8];
            hg_E1(0, bl, kk, qs, vcur, pz, pq, pv, lds, ew, lane);
            HG_BAR();
            for (int n = 0; n < NCH; ++n) {
                hg_E2(n, bl, kk, qs, vcur, lds, ew, lane);
                if (n + 1 < NCH) hg_E1(n + 1, bl, kk, qs, vcur, pz, pq, pv, lds, ew, lane);
                HG_BAR();
            }
            asm volatile("s_waitcnt vmcnt(0)" ::: "memory");
            HG_BAR(); HG_BAR();
        } else {
            const int vt = wave;
            f32x16 S0, S1, S2, S3, acc;
#pragma unroll
            for (int i = 0; i < 16; ++i) { S0[i] = 0.f; S1[i] = 0.f; S2[i] = 0.f; S3[i] = 0.f; acc[i] = 0.f; }
            float gnv[4][4];
#pragma unroll
            for (int g = 0; g < 4; ++g)
#pragma unroll
                for (int j = 0; j < 4; ++j) gnv[g][j] = gn[hd * HD + vt * 32 + 8 * g + 4 * h + j];
            const bf16* pg = proj + (size_t)(b * SEQ + r) * DIN + C_G + hd * HD + vt * 32 + 4 * h;
            f32x16 accp;
#pragma unroll
            for (int i = 0; i < 16; ++i) accp[i] = 0.f;
            HG_BAR();
            for (int n = 0; n < NCH + 2; ++n) {
                const int cm = n - 1, cf = n - 2;
                v2u rg[4];
#pragma unroll
                for (int g = 0; g < 4; ++g) rg[g] = *(const v2u*)(pg + (size_t)(cf >= 0 ? cf : 0) * 32 * DIN + 8 * g);
#pragma unroll
                for (int i = 0; i < 16; ++i) accp[i] = acc[i];
                if (cm >= 0 && cm < NCH) {
                const LAS unsigned char* base = lds + (cm & 1) * HP_SET;
                f32x16 X;
#pragma unroll
                for (int i = 0; i < 16; ++i) { X[i] = 0.f; acc[i] = 0.f; }
                {
                    const LAS unsigned char* pa_k = base + HP_K0 + r * HG_RS + 16 * h; const LAS unsigned char* pb_q = base + HP_QD + r * HG_RS + 16 * h;
                    bf16x8_t ka[8], qb[8];
#pragma unroll
                    for (int ks = 0; ks < 8; ++ks) { ka[ks] = *(const LAS bf16x8_t*)(pa_k + 32 * ks); qb[ks] = *(const LAS bf16x8_t*)(pb_q + 32 * ks); }
#pragma unroll
                    for (int ks = 0; ks < 8; ++ks) X = MFMA32(ka[ks], qb[ks], X);
                }
                {
                    const LAS unsigned char* pq2 = base + HP_QD + r * HG_RS + 8 * h;
                    s16x4_t ql[2][4], qh[2][4];
#pragma unroll
                    for (int s2 = 0; s2 < 2; ++s2)
#pragma unroll
                        for (int kt = 0; kt < 4; ++kt) { ql[s2][kt] = *(const LAS s16x4_t*)(pq2 + (kt * 32 + 16 * s2) * 2); qh[s2][kt] = *(const LAS s16x4_t*)(pq2 + (kt * 32 + 16 * s2 + 8) * 2); }
#pragma unroll
                    for (int s2 = 0; s2 < 2; ++s2) {
                        acc = MFMA32(pack_step(S0, s2), __builtin_shufflevector(ql[s2][0], qh[s2][0], 0, 1, 2, 3, 4, 5, 6, 7), acc);
                        acc = MFMA32(pack_step(S1, s2), __builtin_shufflevector(ql[s2][1], qh[s2][1], 0, 1, 2, 3, 4, 5, 6, 7), acc);
                        acc = MFMA32(pack_step(S2, s2), __builtin_shufflevector(ql[s2][2], qh[s2][2], 0, 1, 2, 3, 4, 5, 6, 7), acc);
                        acc = MFMA32(pack_step(S3, s2), __builtin_shufflevector(ql[s2][3], qh[s2][3], 0, 1, 2, 3, 4, 5, 6, 7), acc);
                    }
                }
#pragma unroll
                for (int i = 0; i < 16; ++i) if (crow_c(i, h) > r) X[i] = 0.f;
                const LAS unsigned char* pvt = base + HP_VN + (4 * h + q4) * HG_VS + (vt * 32 + g16 * 16 + p4 * 4) * 2;
                const LAS unsigned char* pvn = base + HP_VN + (8 * h + q4) * HG_VS + (vt * 32 + g16 * 16 + p4 * 4) * 2;
                const LAS unsigned char* pa = base + HP_K0T + r * HG_TS + 16 * h;
                bf16x8_t va[2], vb[2], kf[2][4];
                hg_tr8(pvt, pvn, va, vb);
#pragma unroll
                for (int s2 = 0; s2 < 2; ++s2)
#pragma unroll
                    for (int kt = 0; kt < 4; ++kt) kf[s2][kt] = *(const LAS bf16x8_t*)(pa + (kt * 32) * HG_TS + 32 * s2);
#pragma unroll
                for (int s2 = 0; s2 < 2; ++s2) acc = MFMA32(va[s2], pack_step(X, s2), acc);
#pragma unroll
                for (int ks = 0; ks < 2; ++ks) { S0 = MFMA32(kf[ks][0], vb[ks], S0); S1 = MFMA32(kf[ks][1], vb[ks], S1); S2 = MFMA32(kf[ks][2], vb[ks], S2); S3 = MFMA32(kf[ks][3], vb[ks], S3); }
                {
                    float ssq = 0.f;
#pragma unroll
                    for (int i = 0; i < 16; ++i) ssq += acc[i] * acc[i];
                    ssq += __shfl_xor(ssq, 32);
                    if (h == 0) *(LAS float*)(lds + HP_NRM + (cm & 1) * 512 + (r * 4 + vt) * 4) = ssq;
                }
                {
                    const LAS unsigned char* pd = base + HP_D + (4 * h) * 4;
#pragma unroll
                    for (int g = 0; g < 4; ++g) { const f32x4 d0 = *(const LAS f32x4*)(pd + (0 * 32 + 8 * g) * 4), d1 = *(const LAS f32x4*)(pd + (1 * 32 + 8 * g) * 4), d2 = *(const LAS f32x4*)(pd + (2 * 32 + 8 * g) * 4), d3 = *(const LAS f32x4*)(pd + (3 * 32 + 8 * g) * 4);
#pragma unroll
                        for (int j = 0; j < 4; ++j) { S0[4 * g + j] *= d0[j]; S1[4 * g + j] *= d1[j]; S2[4 * g + j] *= d2[j]; S3[4 * g + j] *= d3[j]; } }
                }
                }
                if (cf >= 0) {
                {
                    const f32x4 pn = *(const LAS f32x4*)(lds + HP_NRM + (cf & 1) * 512 + r * 16);
                    const float rs = 1.0f / sqrtf(((pn[0] + pn[1]) + (pn[2] + pn[3])) * (1.0f / 128.0f) + EPS);
                    bf16* po = mixed + (size_t)(b * SEQ + cf * 32 + r) * D + DC + hd * HD + vt * 32 + 4 * h;
#pragma unroll
                    for (int g = 0; g < 4; ++g) { const float g0 = bf_lo(rg[g].x), g1 = bf_hi(rg[g].x), g2 = bf_lo(rg[g].y), g3 = bf_hi(rg[g].y);
                        *(v2u*)(po + 8 * g) = (v2u){cvtpk(accp[4 * g] * rs * gnv[g][0] * g0, accp[4 * g + 1] * rs * gnv[g][1] * g1), cvtpk(accp[4 * g + 2] * rs * gnv[g][2] * g2, accp[4 * g + 3] * rs * gnv[g][3] * g3)}; }
                }
                }
                HG_BAR();
            }
        }
        HG_BAR();
    }
}

#ifndef DUP_GOUT
#define DUP_GOUT 0
#endif
#ifndef DUP_NORM
#define DUP_NORM 0
#endif
#ifndef DUP_GIN
#define DUP_GIN 0
#endif
#ifndef DUP_REC
#define DUP_REC 0
#endif
#ifndef DUP_CONV
#define DUP_CONV 0
#endif
#ifndef DUP_GGU
#define DUP_GGU 0
#endif
#ifndef DUP_PRO
#define DUP_PRO 0
#endif
__device__ __forceinline__ void stagger(int bx, int ng, int dticks) {
    const int g = (bx >> 3) % ng; if (g == 0 || dticks == 0) return;
    const unsigned long long t0 = __builtin_amdgcn_s_memrealtime(), dt = (unsigned long long)(g * dticks);
    while (__builtin_amdgcn_s_memrealtime() - t0 < dt) __builtin_amdgcn_s_sleep(8);
}
#ifndef STG_NG
#define STG_NG 4
#endif
#ifndef STG_IN
#define STG_IN 0
#endif
#ifndef STG_OUT
#define STG_OUT 0
#endif
#ifndef STG_GU
#define STG_GU 0
#endif
#ifndef STG_DN
#define STG_DN 0
#endif
struct FixedOrder { int n;
    __device__ bool next(int i, pg8::Unit& u) const { if (i >= n) return false; u.pm = 0; u.pn = 0; return true; }
    __device__ __forceinline__ void a_ready(const pg8::Unit&) const {}
    __device__ __forceinline__ void done(const pg8::Unit&) const {} };
#ifndef PROBE_HALF
#define PROBE_HALF 0
#endif
#ifndef PROBE_FIXED
#define PROBE_FIXED 0
#endif
#ifndef TPROBE
#define TPROBE 0
#endif
#ifndef TP_BLOCK
#define TP_BLOCK 0
#endif
#ifndef TP_MAG
#define TP_MAG 4
#endif
#define TP_B(k) do { if (TPROBE == (k)) tp_t0 = __builtin_amdgcn_s_memrealtime(); } while (0)
#define TP_E(k) do { if (TPROBE == (k)) tp_acc += __builtin_amdgcn_s_memrealtime() - tp_t0; } while (0)
struct Args { const float* in[13]; float* out; unsigned char* ws; int ph_lo, ph_hi; };
__global__ void __launch_bounds__(NTHR, 2) fwd(Args args) {
    extern __shared__ __attribute__((aligned(16))) unsigned char lds_raw[];
    LAS unsigned char* lds = (LAS unsigned char*)lds_raw;
    volatile LAS unsigned* MISC = (volatile LAS unsigned*)(lds + MISC_OFF);
    const int tid = threadIdx.x, lane = tid & 63, wave = __builtin_amdgcn_readfirstlane(tid >> 6);
    const int G = gridDim.x, bx = blockIdx.x, vcu = (G % 8 == 0) ? (bx % 8) * (G / 8) + bx / 8 : bx;
    const int gw = vcu * NWAVES + wave, NGW = G * NWAVES, gtid = vcu * NTHR + tid;
    unsigned char* ws = args.ws;
    unsigned* ctl = (unsigned*)(ws + WS_CTL);
    if (tid < 32) MISC[tid] = 0u;
    __syncthreads();
#if MK_ONE_LAUNCH
    XcdBarrier bar = xcd_barrier_post(ctl + CW_BAR, MISC + 8);
#define GRID_BAR() do { TP_B(1); xcd_barrier(bar); TP_E(1); } while (0)
#else
#define GRID_BAR() do { } while (0)
#endif
    const float* x_in = args.in[0]; const float* norm_mix = args.in[1]; const float* w_in = args.in[2]; const float* conv_w = args.in[3]; const float* gn_conv = args.in[4];
    const float* lb_logits = args.in[5]; const float* gn_hgrn = args.in[6]; const float* w_out = args.in[7]; const float* norm_ffn = args.in[8];
    const float* w_gate = args.in[9]; const float* w_up = args.in[10]; const float* w_down = args.in[11]; const float* norm_final = args.in[12];
    float* out = args.out;
    bf16* HB = (bf16*)(ws + WS_HB); bf16* PROJ = (bf16*)(ws + WS_PROJ);
    const float* LBT = (const float*)(ws + WS_LB);
    const int lo = args.ph_lo, hi = args.ph_hi;
    unsigned long long tp_t0 = 0, tp_acc = 0; (void)tp_t0; (void)tp_acc;
#define IN(k) (lo <= (k) && (k) < hi)
#define SEAM(k) do { if (IN((k) + 1)) GRID_BAR(); } while (0)

    bf16* XB = (bf16*)((unsigned char*)out + (size_t)M * D * 2);
    float* SS = (float*)(ws + WS_SS);
    LAS float* PSS = (LAS float*)(lds + PSS_OFF); LAS float* RST = (LAS float*)(lds + RST_OFF);
    if (IN(0)) { TP_B(10);
        weights_phase(w_in, w_out, w_gate, w_up, w_down, norm_mix, norm_ffn, ws, lds, 0, DEPTH, gw, NGW, wave, lane);
        xconv_phase(x_in, XB, SS, lb_logits, (float*)(ws + WS_LB), gw, NGW, lane, gtid);
        TP_E(10); SEAM(0); }
    for (int l = 0; l < DEPTH; ++l) {
        const int p = 1 + 5 * l;
        int tq = threadIdx.x; asm volatile("" : "+v"(tq));
        const int tid = tq, lane = tq & 63;
        if (IN(p + 0)) {
            TP_B(4);
            pg8::Gemm g{XB, (const bf16*)(ws + WS_WIN + l * SZ_WIN), M, DIN, D}; pg8::StaticOrder S; S.init(M, DIN, G, bx); pg8::EpiProj E{PROJ, DIN, LBT + l * DH, SS, RST};
            if (tid == 0) RST[0] = 0.f; __syncthreads();
            pg8::gemm_phase<pg8::EpiProj, pg8::StaticOrder, PG8_ALIGNV, PG8_SP2V>(lds + RING_OFF, g, S, E, tp_acc);
#if PROBE_FIXED
            {
                const bool active = PROBE_HALF == 0 ? true : (PROBE_HALF == 1 ? (bx & 7) < 4 : ((bx >> 3) & 1) == 0);
                if (active) { pg8::StaticOrder S2; S2.init(M, DIN, G, bx); S2.fixed = 14; pg8::EpiProj E2{(bf16*)(ws + WS_END) + (size_t)bx * 65536, 256, LBT + l * DH, SS, RST};
                    pg8::gemm_phase<pg8::EpiProj, pg8::StaticOrder, PG8_ALIGNV, PG8_SP2V>(lds + RING_OFF, g, S2, E2, tp_acc); } }
#endif
            TP_E(4); SEAM(p + 0); }
        if (IN(p + 1)) {
            const int idx = (bx & 7) + 8 * (bx >> 4);
            if (((bx >> 3) & 1) == 0) { unsigned long long c40 = 0; if (TPROBE == 40) c40 = __builtin_amdgcn_s_memtime(); TP_B(7); hgrn_chunk_phase(PROJ, gn_hgrn + l * DH, HB, BATCH * HEADS, idx, G >> 1, lds + RING_OFF, tid, wave, lane, tp_acc); TP_E(7); if (TPROBE == 40) tp_acc += (__builtin_amdgcn_s_memtime() - c40) / 10; }
            else { TP_B(8); const int gwc = ((idx & 7) * (G >> 4) + (idx >> 3)) * NWAVES + wave, ngwc = (G >> 1) * NWAVES;
                conv_phase(PROJ, conv_w + l * 3 * DC, gn_conv + l * DC, HB, gwc, ngwc, lane);
                TP_E(8); }
            SEAM(p + 1); }
        if (IN(p + 2)) {
            TP_B(3);
            pg8::Gemm g{HB, (const bf16*)(ws + WS_WOUT + l * SZ_WOUT), M, D, D}; pg8::StaticOrder S; S.init(M, D, G, bx); pg8::EpiResBf16 E{XB, XB, D, SS, PSS};
            pg8::gemm_phase<pg8::EpiResBf16, pg8::StaticOrder, true, PG8_SP2V>(lds + RING_OFF, g, S, E, tp_acc);
            TP_E(3); SEAM(p + 2); }
        unsigned long long c41 = 0;
        if (IN(p + 3)) {
            TP_B(5); if (TPROBE == 41) c41 = __builtin_amdgcn_s_memtime();
            pg8::Gemm g{XB, (const bf16*)(ws + WS_WGU + l * SZ_WGU), M, NGU, D}; pg8::StaticOrder S; S.init(M, NGU, G, bx); pg8::EpiSwiGLU E{PROJ, DFF, SS, RST};
            if (tid == 0) RST[0] = 0.f; __syncthreads();
            pg8::gemm_phase<pg8::EpiSwiGLU, pg8::StaticOrder, PG8_ALIGNV, PG8_SP2V>(lds + RING_OFF, g, S, E, tp_acc);
            TP_E(5); if (TPROBE == 41) tp_acc += (__builtin_amdgcn_s_memtime() - c41) / 10; SEAM(p + 3); }
        if (IN(p + 4)) {
            TP_B(2);
            pg8::Gemm g{PROJ, (const bf16*)(ws + WS_WDN + l * SZ_WDN), M, D, DFF}; pg8::StaticOrder S; S.init(M, D, G, bx); pg8::EpiResBf16 E{XB, l == DEPTH - 1 ? HB : XB, D, SS, PSS};
            pg8::gemm_phase<pg8::EpiResBf16, pg8::StaticOrder, true, PG8_SP2V>(lds + RING_OFF, g, S, E, tp_acc);
            TP_E(2); SEAM(p + 4); }
    }
    if (IN(NPH - 1)) { TP_B(11); final_norm_phase(HB, norm_final, out, gw, NGW, lane); TP_E(11); }
#if TPROBE
    if (bx == TP_BLOCK && tid == ((TPROBE >= 33 && TPROBE <= 36) ? 256 : 0)) { const unsigned long long t0 = __builtin_amdgcn_s_memrealtime(), dt = tp_acc * TP_MAG; while (__builtin_amdgcn_s_memrealtime() - t0 < dt) __builtin_amdgcn_s_sleep(16); }
#endif
#undef IN
#undef SEAM
}

extern "C" void kernel_launch(void* const* d_in, const int* in_sizes, int n_in, void* d_out, int out_size, void* d_ws, size_t ws_size, hipStream_t stream) {
    static int grid = 0;
    if (grid == 0) {
        if (n_in != 13 || in_sizes[0] != M * D || out_size != M * D || ws_size < WS_END) { fprintf(stderr, "kernel_launch: unexpected shapes (n_in %d, in0 %d, out %d, ws %zu < %zu); nothing launched\n", n_in, n_in > 0 ? in_sizes[0] : -1, out_size, ws_size, (size_t)WS_END); grid = -1; return; }
        int dev = 0, cus = 0;
        if (hipGetDevice(&dev) != hipSuccess || hipDeviceGetAttribute(&cus, hipDeviceAttributeMultiprocessorCount, dev) != hipSuccess) { grid = -1; return; }
        if (hipFuncSetAttribute((const void*)fwd, hipFuncAttributeMaxDynamicSharedMemorySize, LDS_BYTES) != hipSuccess) { fprintf(stderr, "kernel_launch: hipFuncSetAttribute failed\n"); grid = -1; return; }
        (void)hipGetLastError();
        grid = cus;
    }
    if (grid < 0) return;
    (void)hipMemsetAsync((char*)d_ws + WS_CTL, 0, CTL_ZERO_BYTES, stream);
    Args a{};
    for (int i = 0; i < 13; ++i) a.in[i] = (const float*)d_in[i];
    a.out = (float*)d_out; a.ws = (unsigned char*)d_ws;
#if MK_ONE_LAUNCH
    a.ph_lo = 0; a.ph_hi = NPH;
    hipLaunchKernelGGL(fwd, dim3(grid), dim3(NTHR), LDS_BYTES, stream, a);
#else
    for (int p = 0; p < NPH; ++p) { a.ph_lo = p; a.ph_hi = p + 1; hipLaunchKernelGGL(fwd, dim3(grid), dim3(NTHR), LDS_BYTES, stream, a); }
#endif
}
```

```cpp
#include <hip/hip_runtime.h>
#include <cstdio>
#include <cstdint>
#define MK_ONE_LAUNCH 1
#define PG8_WGM 4
#ifndef RELAX_EPI
#define RELAX_EPI 1
#endif
#ifndef PG8_WGM
#define PG8_WGM 8
#endif
#ifndef PG8_SP2V
#define PG8_SP2V true
#endif
#ifndef PG8_ALIGNV
#define PG8_ALIGNV true
#endif
#ifndef TPROBE
#define TPROBE 0
#endif
__device__ __forceinline__ int fresh_lane() { int l; asm volatile("v_mbcnt_lo_u32_b32 %0, -1, 0\n\tv_mbcnt_hi_u32_b32 %0, -1, %0" : "=v"(l)); return l & 63; }
namespace pg8 {
#define PG8_LAS __attribute__((address_space(3)))
typedef unsigned short bf16_t;
typedef short bf16x8 __attribute__((ext_vector_type(8)));
typedef float f32x4 __attribute__((ext_vector_type(4)));
typedef unsigned u32x4 __attribute__((ext_vector_type(4)));
constexpr int BM = 256, BK = 64, HALF = 128, HTB = HALF * BK * 2  , STAGE_BYTES = 8 * HTB, NXCD = 8, WGM = PG8_WGM;

__host__ __device__ __forceinline__ int lds_byte(int r, int c) { const int st = (r >> 4) * 2 + (c >> 5), rr = r & 15, cc = c & 31, ob = rr * 64 + cc * 2; return st * 1024 + (ob ^ (((ob >> 9) & 1) << 5)); }
__host__ __device__ __forceinline__ void stage_rc(int b, int& R, int& C) { const int st = b / 1024, sb = b % 1024, swz = sb ^ (((sb >> 9) & 1) << 5); R = (st >> 1) * 16 + swz / 64; C = (st & 1) * 32 + (swz % 64) / 2; }
__host__ __device__ __forceinline__ int perm32(int rho) { const int n = rho >> 4, i = rho & 15; return 8 * (i >> 2) + 4 * n + (i & 3); }

struct Unit { int pm, pn; };
struct Gemm { const bf16_t* A; const bf16_t* Bt; int M, N, K; };

#ifndef PG8_XSWAP
#define PG8_XSWAP 0
#endif
struct StaticOrder {
    int nM, nN, nwg, G, c; int fixed = 0;
    __host__ __device__ void init(int M, int N, int G_, int c_) { nM = M / BM; nN = N / BM; nwg = nM * nN; G = G_; c = c_; }
    __host__ __device__ bool next(int i, Unit& u) const {
        if (fixed) { if (i >= fixed) return false; u.pm = 0; u.pn = 0; return true; }
        const long L = (long)i * G + c; if (L >= nwg) return false;
        int wgid = (int)L; { const int q = nwg / NXCD, r = nwg % NXCD, xcd = (wgid % NXCD) ^ PG8_XSWAP, off = wgid / NXCD; wgid = (xcd < r ? xcd * (q + 1) : r * (q + 1) + (xcd - r) * q) + off; }
        const int nig = WGM * nN, gid = wgid / nig, fm = gid * WGM, gsz = (nM - fm) < WGM ? (nM - fm) : WGM;
        u.pm = fm + ((wgid % nig) % gsz); u.pn = (wgid % nig) / gsz; return true;
    }
    __device__ __forceinline__ void a_ready(const Unit&) const {}
    __device__ __forceinline__ void done(const Unit&) const {}
};

__device__ __forceinline__ unsigned cvt_pk_bf16(float lo, float hi) { unsigned r; asm volatile("v_cvt_pk_bf16_f32 %0, %1, %2" : "=v"(r) : "v"(lo), "v"(hi)); return r; }
typedef float f32x2 __attribute__((ext_vector_type(2)));
#if defined(NT_STORES) && NT_STORES
#define ST16(p, v) __builtin_nontemporal_store((v), (u32x4*)(p))
#else
#define ST16(p, v) (*(u32x4*)(p) = (v))
#endif
__device__ __forceinline__ float silu_f(float x) { return x * __builtin_amdgcn_rcpf(1.0f + __builtin_amdgcn_exp2f(-1.44269504089f * x)); }
__device__ __forceinline__ void row_scale_table(const float* ss, PG8_LAS float* RS, int pm, int t) {
    const int tag = __builtin_amdgcn_readfirstlane(__float_as_int(RS[0]));
    if (tag != pm + 1) {
        asm volatile("s_waitcnt lgkmcnt(0)" ::: "memory"); __builtin_amdgcn_s_barrier(); asm volatile("" ::: "memory");
        if (t < BM) { const f32x4* p = (const f32x4*)(ss + (size_t)(pm * BM + t) * 8); const f32x4 a = p[0], b = p[1];
            RS[4 + t] = 1.0f / __builtin_sqrtf((((a[0] + a[1]) + (a[2] + a[3])) + ((b[0] + b[1]) + (b[2] + b[3]))) * (1.0f / 2048.0f) + 1e-6f);
            if (t == 0) RS[0] = __int_as_float(pm + 1); }
        asm volatile("s_waitcnt lgkmcnt(0)" ::: "memory"); __builtin_amdgcn_s_barrier(); asm volatile("" ::: "memory");
    }
}
struct EpiBf16Plain {
    static constexpr bool PERM = true, AFTER_DRAIN = false; static constexpr int NST = 16;
    static __device__ __forceinline__ int relax_class(const Unit&) { return 1; }
    bf16_t* O; int ldc;
    __device__ __forceinline__ void operator()(const f32x4 (&acc)[2][2][4][2], const Unit& u, int wr, int wc, int fr, int fq) const {
        const int row0 = u.pm * BM + wr * 64 + fr, col0 = u.pn * BM + wc * 32 + 8 * fq;
#pragma unroll
        for (int ai = 0; ai < 2; ++ai)
#pragma unroll
            for (int m = 0; m < 4; ++m) { bf16_t* rowp = O + (size_t)(row0 + ai * HALF + m * 16) * ldc + col0;
#pragma unroll
                for (int bj = 0; bj < 2; ++bj) { const f32x4 v0 = acc[ai][bj][m][0], v1 = acc[ai][bj][m][1];
                    u32x4 w; w.x = cvt_pk_bf16(v0[0], v0[1]); w.y = cvt_pk_bf16(v0[2], v0[3]); w.z = cvt_pk_bf16(v1[0], v1[1]); w.w = cvt_pk_bf16(v1[2], v1[3]);
                    *(u32x4*)(rowp + bj * HALF) = w; } }
    }
};
struct EpiProj {
    static constexpr bool PERM = true, AFTER_DRAIN = false; static constexpr int NST = 16;
    bf16_t* O; int ldc; const PG8_LAS float* lbt; const float* ss; PG8_LAS float* RS;
    static __device__ __forceinline__ int relax_class(const Unit& u) { return ((u.pn >> 2) == 1 || (u.pn >> 2) == 2) ? 2 : 1; }
    __device__ __forceinline__ void operator()(const f32x4 (&acc)[2][2][4][2], const Unit& u, int wr, int wc, int fr_, int fq_) const {
        const int ln = fresh_lane();
        const int fr = ln & 15, fq = ln >> 4; (void)fr_; (void)fq_;
        const int kind = u.pn >> 2; const bool prod = kind == 1 || kind == 2;
        const int row0 = u.pm * BM + wr * 64 + fr, col0 = (prod ? 1024 + (u.pn - 4) * HALF : u.pn * BM) + wc * 32 + 8 * fq;
        row_scale_table(ss, RS, u.pm, (wr * 4 + wc) * 64 + fq * 16 + fr);
#pragma unroll
        for (int ai = 0; ai < 2; ++ai) { float rs[4];
#pragma unroll
            for (int m = 0; m < 4; ++m) rs[m] = RS[4 + ai * HALF + wr * 64 + m * 16 + fr];
#pragma unroll
            for (int m = 0; m < 4; ++m) { int mrow = row0 + ai * HALF + m * 16; asm volatile("" : "+v"(mrow) :: "memory");
                bf16_t* rowp = O + (size_t)mrow * ldc + col0;
#pragma unroll
                for (int bj = 0; bj < 2; ++bj) { f32x4 v[2] = {acc[ai][bj][m][0] * rs[m], acc[ai][bj][m][1] * rs[m]};
                    if (kind == 3 || kind == 6) {
#pragma unroll
                        for (int n = 0; n < 2; ++n)
#pragma unroll
                            for (int j = 0; j < 4; ++j) v[n][j] = silu_f(v[n][j]);
                    } else if (kind == 4) {
#pragma unroll
                        for (int n = 0; n < 2; ++n)
                        { const f32x4 lbv = *(const PG8_LAS f32x4*)(lbt + (col0 - 4096) + bj * HALF + 4 * n);
#pragma unroll
                            for (int j = 0; j < 4; ++j) { const float z = v[n][j], t = __builtin_amdgcn_exp2f(-1.44269504089f * __builtin_fabsf(z)), ri = __builtin_amdgcn_rcpf(1.0f + t);
                                const float sig = z >= 0.f ? ri : t * ri, lb = lbv[j]; v[n][j] = __builtin_amdgcn_logf(__builtin_fmaxf(lb + (1.0f - lb) * sig, 1e-30f)); } }
                    } else if (prod) { v[0] = v[0] * (acc[ai][bj ^ 1][m][0] * rs[m]); v[1] = v[1] * (acc[ai][bj ^ 1][m][1] * rs[m]); if (bj == 1) continue; }
                    u32x4 w; w.x = cvt_pk_bf16(v[0][0], v[0][1]); w.y = cvt_pk_bf16(v[0][2], v[0][3]); w.z = cvt_pk_bf16(v[1][0], v[1][1]); w.w = cvt_pk_bf16(v[1][2], v[1][3]);
                    ST16(rowp + bj * HALF, w); } } }
    }
};
struct EpiResBf16 {
    static constexpr bool PERM = true, AFTER_DRAIN = false; static constexpr int NST = 16;
    static __device__ __forceinline__ int relax_class(const Unit&) { return 1; }
    const bf16_t* res; bf16_t* out; int ldc; float* ss; PG8_LAS float* P;
    __device__ __forceinline__ void operator()(const f32x4 (&acc)[2][2][4][2], const Unit& u, int wr, int wc, int fr, int fq) const {
        const int row0 = u.pm * BM + wr * 64 + fr, col0 = u.pn * BM + wc * 32 + 8 * fq;
        u32x4 r[2][4][2];
#pragma unroll
        for (int ai = 0; ai < 2; ++ai)
#pragma unroll
            for (int m = 0; m < 4; ++m)
#pragma unroll
                for (int bj = 0; bj < 2; ++bj) r[ai][m][bj] = *(const u32x4*)(res + (size_t)(row0 + ai * HALF + m * 16) * ldc + col0 + bj * HALF);
        asm volatile("" ::: "memory");
#pragma unroll
        for (int ai = 0; ai < 2; ++ai) {
#pragma unroll
            for (int m = 0; m < 4; ++m) { float s = 0.f;
#pragma unroll
                for (int bj = 0; bj < 2; ++bj) { const u32x4 q = r[ai][m][bj]; const f32x4 a0 = acc[ai][bj][m][0], a1 = acc[ai][bj][m][1]; u32x4 w;
                    w.x = cvt_pk_bf16(__uint_as_float(q.x << 16) + a0[0], __uint_as_float(q.x & 0xffff0000u) + a0[1]); w.y = cvt_pk_bf16(__uint_as_float(q.y << 16) + a0[2], __uint_as_float(q.y & 0xffff0000u) + a0[3]);
                    w.z = cvt_pk_bf16(__uint_as_float(q.z << 16) + a1[0], __uint_as_float(q.z & 0xffff0000u) + a1[1]); w.w = cvt_pk_bf16(__uint_as_float(q.w << 16) + a1[2], __uint_as_float(q.w & 0xffff0000u) + a1[3]);
                    *(u32x4*)(out + (size_t)(row0 + ai * HALF + m * 16) * ldc + col0 + bj * HALF) = w;
#pragma unroll
                    for (int e = 0; e < 4; ++e) { const float lo = __uint_as_float(w[e] << 16), hi = __uint_as_float(w[e] & 0xffff0000u); s += lo * lo + hi * hi; } }
                s += __shfl_xor(s, 16); s += __shfl_xor(s, 32);
                if (fq == 0) P[(ai * HALF + wr * 64 + m * 16 + fr) * 4 + wc] = s; }
            asm volatile("" ::: "memory");
        }
        asm volatile("s_waitcnt lgkmcnt(0)" ::: "memory"); __builtin_amdgcn_s_barrier(); asm volatile("" ::: "memory");
        const int t = (wr * 4 + wc) * 64 + fq * 16 + fr;
        if (t < BM) { const f32x4 p = *(const PG8_LAS f32x4*)(P + t * 4); ss[(size_t)(u.pm * BM + t) * 8 + u.pn] = (p[0] + p[1]) + (p[2] + p[3]); }
    }
};
struct EpiSwiGLU {
    static constexpr bool PERM = true, AFTER_DRAIN = false; static constexpr int NST = 8;
    static __device__ __forceinline__ int relax_class(const Unit&) { return 1; }
    bf16_t* H; int ldh; const float* ss; PG8_LAS float* RS;
    __device__ __forceinline__ void operator()(const f32x4 (&acc)[2][2][4][2], const Unit& u, int wr, int wc, int fr, int fq) const {
        const int row0 = u.pm * BM + wr * 64 + fr, col0 = u.pn * HALF + wc * 32 + 8 * fq;
        row_scale_table(ss, RS, u.pm, (wr * 4 + wc) * 64 + fq * 16 + fr);
#pragma unroll
        for (int ai = 0; ai < 2; ++ai) { float rs[4];
#pragma unroll
            for (int m = 0; m < 4; ++m) rs[m] = RS[4 + ai * HALF + wr * 64 + m * 16 + fr];
#pragma unroll
            for (int m = 0; m < 4; ++m) { bf16_t* rowp = H + (size_t)(row0 + ai * HALF + m * 16) * ldh + col0;
                const f32x4 g0 = acc[ai][0][m][0] * rs[m], g1 = acc[ai][0][m][1] * rs[m], u0 = acc[ai][1][m][0] * rs[m], u1 = acc[ai][1][m][1] * rs[m];
                u32x4 w; w.x = cvt_pk_bf16(silu_f(g0[0]) * u0[0], silu_f(g0[1]) * u0[1]); w.y = cvt_pk_bf16(silu_f(g0[2]) * u0[2], silu_f(g0[3]) * u0[3]);
                w.z = cvt_pk_bf16(silu_f(g1[0]) * u1[0], silu_f(g1[1]) * u1[1]); w.w = cvt_pk_bf16(silu_f(g1[2]) * u1[2], silu_f(g1[3]) * u1[3]);
                ST16(rowp, w); } }
    }
};

template <class Epi, class Sched, bool ALIGN_EPI = false, bool SP2 = false>
__device__ __forceinline__ void gemm_phase(PG8_LAS unsigned char* lds, const Gemm g, const Sched& S, const Epi& E, unsigned long long& gp_acc, const int wave) {
    unsigned long long gp_t0 = 0; (void)gp_t0; (void)gp_acc;
#define GP_B(k) do { if (TPROBE == (k)) gp_t0 = __builtin_amdgcn_s_memrealtime(); } while (0)
#define GP_E(k) do { if (TPROBE == (k)) gp_acc += __builtin_amdgcn_s_memrealtime() - gp_t0; } while (0)
    int wid_ = wave; asm volatile("" : "+s"(wid_));
    const int wid = wid_ & 7, lane = fresh_lane(), tid = wid * 64 + lane,
              wr = wid >> 2, wc = wid & 3, fr = lane & 15, fq = lane >> 4;
    const int K = g.K, nt = K / BK;
    unsigned voffA, voffB;
    { int R, C; stage_rc(tid * 16, R, C); const int Rb = Epi::PERM ? ((R & ~31) + perm32(R & 31)) : R; voffA = (unsigned)(R * K + C) * 2u; voffB = (unsigned)(Rb * K + C) * 2u; }
    const size_t rstep = (size_t)64 * K * 2;
    const size_t kstep = (size_t)(BK * 2);
    const size_t hstep = (size_t)HALF * K * 2;
    const size_t tstep = 2 * hstep;
    const unsigned ldsw = (unsigned)wid * 1024u;
    const int aoff = lds_byte(wr * 64 + fr, fq * 8), boff = lds_byte(wc * 32 + fr, fq * 8);
#define PG8_SA(b, h) (((b) * 2 + (h)) * HTB)
#define PG8_SB(b, h) ((4 + (b) * 2 + (h)) * HTB)
#define PG8_STAGE(bufoff, gbase, voff) do { _Pragma("unroll") for (int _i = 0; _i < 2; ++_i) \
        __builtin_amdgcn_global_load_lds((const unsigned*)((const char*)(gbase) + _i * rstep + (voff)), (PG8_LAS unsigned*)(lds + (bufoff) + ldsw + _i * 8192), 16, 0, 0); } while (0)
#define PG8_LDA(dst, b, h) do { _Pragma("unroll") for (int m = 0; m < 4; ++m) _Pragma("unroll") for (int k = 0; k < 2; ++k) dst[m][k] = *(const PG8_LAS bf16x8*)(lds + PG8_SA(b, h) + aoff + m * 2048 + k * 1024); } while (0)
#define PG8_LDB(dst, b, h) do { _Pragma("unroll") for (int n = 0; n < 2; ++n) _Pragma("unroll") for (int k = 0; k < 2; ++k) dst[n][k] = *(const PG8_LAS bf16x8*)(lds + PG8_SB(b, h) + boff + n * 2048 + k * 1024); } while (0)
#define PG8_MMA(ai, bj, At, Bt) do { __builtin_amdgcn_s_setprio(1); _Pragma("unroll") for (int m = 0; m < 4; ++m) _Pragma("unroll") for (int n = 0; n < 2; ++n) _Pragma("unroll") for (int k = 0; k < 2; ++k) \
        acc[ai][bj][m][n] = __builtin_amdgcn_mfma_f32_16x16x32_bf16(Bt[n][k], At[m][k], acc[ai][bj][m][n], 0, 0, 0); __builtin_amdgcn_s_setprio(0); } while (0)
#define PG8_WAIT_V(n) asm volatile("s_waitcnt vmcnt(" #n ")" ::: "memory")
#define PG8_WAIT_V8R do { if constexpr (Epi::NST == 16) asm volatile("s_waitcnt vmcnt(24)\n\ts_cmp_eq_u32 %0, 1\n\ts_cbranch_scc1 1f\n\ts_waitcnt vmcnt(16)\n\ts_cmp_eq_u32 %0, 2\n\ts_cbranch_scc1 1f\n\ts_waitcnt vmcnt(8)\n1:" :: "s"(relax) : "memory", "scc");     \
        else if constexpr (Epi::NST == 8) asm volatile("s_waitcnt vmcnt(16)\n\ts_cmp_lg_u32 %0, 0\n\ts_cbranch_scc1 1f\n\ts_waitcnt vmcnt(8)\n1:" :: "s"(relax) : "memory", "scc"); \
        else asm volatile("s_waitcnt vmcnt(8)" ::: "memory"); } while (0)
#define PG8_WAIT_L(n) asm volatile("s_waitcnt lgkmcnt(" #n ")" ::: "memory")
#define PG8_BAR __builtin_amdgcn_s_barrier()
#define PG8_SCHED __builtin_amdgcn_sched_barrier(0)
    Unit cur, nxt; int ui = 0, rcls = 1;
    if (!S.next(0, cur)) return;
    f32x4 acc[2][2][4][2];
#pragma unroll
    for (int a = 0; a < 2; ++a)
#pragma unroll
        for (int b = 0; b < 2; ++b)
#pragma unroll
            for (int m = 0; m < 4; ++m)
#pragma unroll
                for (int n = 0; n < 2; ++n) acc[a][b][m][n] = (f32x4){0.f, 0.f, 0.f, 0.f};
    bf16x8 At[4][2], B0[2][2], B1[2][2];
    const char* cA = (const char*)g.A + (size_t)cur.pm * tstep; const char* cB = (const char*)g.Bt + (size_t)cur.pn * tstep;
    S.a_ready(cur);
    if constexpr (SP2) {
        PG8_STAGE(PG8_SB(0, 0), cB, voffB); PG8_STAGE(PG8_SB(0, 1), cB + hstep, voffB); PG8_STAGE(PG8_SA(0, 0), cA, voffA); PG8_STAGE(PG8_SA(0, 1), cA + hstep, voffA);
        if (wr == 1) PG8_BAR;
        PG8_WAIT_V(2); PG8_BAR;
        PG8_STAGE(PG8_SB(1, 0), cB + kstep, voffB); PG8_STAGE(PG8_SA(1, 0), cA + kstep, voffA); PG8_STAGE(PG8_SB(1, 1), cB + hstep + kstep, voffB);
        PG8_WAIT_V(6); PG8_BAR;
    } else {
        PG8_STAGE(PG8_SB(0, 0), cB, voffB); PG8_STAGE(PG8_SA(0, 0), cA, voffA); PG8_STAGE(PG8_SB(0, 1), cB + hstep, voffB); PG8_STAGE(PG8_SA(0, 1), cA + hstep, voffA);
        if (wr == 1) PG8_BAR;
        PG8_WAIT_V(4); PG8_BAR;
        PG8_STAGE(PG8_SB(1, 0), cB + kstep, voffB); PG8_STAGE(PG8_SA(1, 0), cA + kstep, voffA); PG8_STAGE(PG8_SB(1, 1), cB + hstep + kstep, voffB);
        PG8_WAIT_V(6); PG8_BAR;
    }
    for (;;) {
        const bool has_next = S.next(ui + 1, nxt);
        const char* nA = has_next ? (const char*)g.A + (size_t)nxt.pm * tstep : cA; const char* nB = has_next ? (const char*)g.Bt + (size_t)nxt.pn * tstep : cB;
        for (int t = 0; t < nt; t += 2) {
            const bool last = (t == nt - 2); const int relax = __builtin_amdgcn_readfirstlane((RELAX_EPI && (t == 0) && (ui > 0)) ? rcls : 0);
            const char* a1 = cA + (size_t)(t + 1) * kstep;
            const char* a2 = last ? nA : cA + (size_t)(t + 2) * kstep; const char* b2 = last ? nB : cB + (size_t)(t + 2) * kstep;
            const char* a3 = a2 + kstep; const char* b3 = b2 + kstep;
            if (last && has_next) S.a_ready(nxt);
            if (t == 0) GP_B(21); GP_B(22);
            if constexpr (SP2) {
            PG8_LDB(B0, 0, 0); PG8_LDB(B1, 0, 1); PG8_SCHED; PG8_LDA(At, 0, 0); PG8_STAGE(PG8_SA(1, 1), a1 + hstep, voffA);
            PG8_WAIT_V8R; PG8_WAIT_L(0); PG8_BAR; PG8_MMA(0, 0, At, B0); PG8_MMA(0, 1, At, B1); PG8_BAR; PG8_SCHED;
            PG8_LDA(At, 0, 1); PG8_STAGE(PG8_SB(0, 0), b2, voffB); PG8_STAGE(PG8_SB(0, 1), b2 + hstep, voffB); PG8_STAGE(PG8_SA(0, 0), a2, voffA);
            PG8_WAIT_V8R; PG8_WAIT_L(0); PG8_BAR; PG8_MMA(1, 0, At, B0); PG8_MMA(1, 1, At, B1); PG8_BAR; PG8_SCHED;
            PG8_LDB(B0, 1, 0); PG8_LDB(B1, 1, 1); PG8_SCHED; PG8_LDA(At, 1, 0); PG8_STAGE(PG8_SA(0, 1), a2 + hstep, voffA);
            PG8_WAIT_V(8); PG8_WAIT_L(0); PG8_BAR; PG8_MMA(0, 0, At, B0); PG8_MMA(0, 1, At, B1); PG8_BAR; PG8_SCHED;
            PG8_LDA(At, 1, 1); PG8_STAGE(PG8_SB(1, 0), b3, voffB); PG8_STAGE(PG8_SB(1, 1), b3 + hstep, voffB); PG8_STAGE(PG8_SA(1, 0), a3, voffA);
            PG8_WAIT_V(8); PG8_WAIT_L(0); PG8_BAR; PG8_MMA(1, 0, At, B0); PG8_MMA(1, 1, At, B1); PG8_BAR; PG8_SCHED;
            } else {
            PG8_LDB(B0, 0, 0); PG8_SCHED; PG8_LDA(At, 0, 0); PG8_STAGE(PG8_SA(1, 1), a1 + hstep, voffA);
            PG8_WAIT_L(8); PG8_BAR; PG8_WAIT_L(0); PG8_MMA(0, 0, At, B0); PG8_BAR; PG8_SCHED;
            PG8_LDB(B1, 0, 1); PG8_STAGE(PG8_SB(0, 0), b2, voffB);
            PG8_BAR; PG8_WAIT_L(0); PG8_MMA(0, 1, At, B1); PG8_BAR;
            PG8_LDA(At, 0, 1); PG8_STAGE(PG8_SA(0, 0), a2, voffA);
            PG8_BAR; PG8_WAIT_L(0); PG8_MMA(1, 0, At, B0); PG8_BAR; PG8_SCHED;
            PG8_STAGE(PG8_SB(0, 1), b2 + hstep, voffB);
            PG8_WAIT_V(6); PG8_BAR; PG8_MMA(1, 1, At, B1); PG8_BAR;
            PG8_LDB(B0, 1, 0); PG8_SCHED; PG8_LDA(At, 1, 0); PG8_STAGE(PG8_SA(0, 1), a2 + hstep, voffA);
            PG8_WAIT_L(8); PG8_BAR; PG8_WAIT_L(0); PG8_MMA(0, 0, At, B0); PG8_BAR; PG8_SCHED;
            PG8_LDB(B1, 1, 1); PG8_STAGE(PG8_SB(1, 0), b3, voffB);
            PG8_BAR; PG8_WAIT_L(0); PG8_MMA(0, 1, At, B1); PG8_BAR;
            PG8_LDA(At, 1, 1); PG8_STAGE(PG8_SA(1, 0), a3, voffA);
            PG8_BAR; PG8_WAIT_L(0); PG8_MMA(1, 0, At, B0); PG8_BAR; PG8_SCHED;
            PG8_STAGE(PG8_SB(1, 1), b3 + hstep, voffB);
            PG8_WAIT_V(6); PG8_BAR; PG8_MMA(1, 1, At, B1); PG8_BAR;
            }
            if (t == 0) GP_E(21); GP_E(22);
        }
        if constexpr (ALIGN_EPI) { if (wr == 0) PG8_BAR; }
        GP_B(20);
        if constexpr (!Epi::AFTER_DRAIN) { E(acc, cur, wr, wc, fr, fq);
#if defined(DUP_EPI) && DUP_EPI
            if constexpr (Epi::PERM) { asm volatile("" ::: "memory"); E(acc, cur, wr, wc, fr, fq); }
#endif
            S.done(cur); }
        GP_E(20);
        if (!has_next) break;
#pragma unroll
        for (int a = 0; a < 2; ++a)
#pragma unroll
            for (int b = 0; b < 2; ++b)
#pragma unroll
                for (int m = 0; m < 4; ++m)
#pragma unroll
                    for (int n = 0; n < 2; ++n) acc[a][b][m][n] = (f32x4){0.f, 0.f, 0.f, 0.f};
        rcls = Epi::relax_class(cur); cur = nxt; cA = nA; cB = nB; ++ui;
        if constexpr (ALIGN_EPI) { if (wr == 1) PG8_BAR; }
    }
    PG8_WAIT_V(0);
    if constexpr (!ALIGN_EPI) { if (wr == 0) PG8_BAR; }
    PG8_BAR;
    if constexpr (Epi::AFTER_DRAIN) { E.fused(acc, cur, wr, wc, fr, fq, lds, wid, lane); S.done(cur); }
#undef PG8_SA
#undef PG8_SB
#undef PG8_STAGE
#undef PG8_LDA
#undef PG8_LDB
#undef PG8_MMA
#undef PG8_WAIT_V
#undef PG8_WAIT_V8R
#undef PG8_WAIT_L
#undef PG8_BAR
#undef PG8_SCHED
#undef GP_B
#undef GP_E
}
}

constexpr int NWAVES = 8, NTHR = 512;
constexpr int D = 2048, BATCH = 16, SEQ = 2048, M = BATCH * SEQ, DEPTH = 4;
constexpr int DC = 1024, DH = 1024, DIN = 7168, DFF = 5632, NGU = 2 * DFF, HEADS = 8, HD = 128;
constexpr int C_B = 0, C_C = 1024, C_H = 2048, C_Q = 3072, C_Z = 4096, C_I = 5120, C_G = 6144;
constexpr int C_U = 1024;
constexpr float EPS = 1e-6f;
#ifndef MK_ONE_LAUNCH
#define MK_ONE_LAUNCH 1
#endif
constexpr int NPH = 2 + 5 * DEPTH;

constexpr size_t MiB = 1u << 20;
constexpr size_t WS_CTL = 0, CTL_ZERO_BYTES = 1 * MiB;
constexpr size_t WS_LB = 1 * MiB;
constexpr size_t WS_SS = 2 * MiB;
constexpr size_t WS_WIN = 3 * MiB, SZ_WIN = (size_t)DIN * D * 2;
constexpr size_t WS_WOUT = WS_WIN + DEPTH * SZ_WIN, SZ_WOUT = (size_t)D * D * 2;
constexpr size_t WS_WGU = WS_WOUT + DEPTH * SZ_WOUT, SZ_WGU = (size_t)NGU * D * 2;
constexpr size_t WS_WDN = WS_WGU + DEPTH * SZ_WGU, SZ_WDN = (size_t)D * DFF * 2;
constexpr size_t WS_HB = WS_WDN + DEPTH * SZ_WDN;
constexpr size_t WS_PROJ = WS_HB + (size_t)M * D * 2;
constexpr size_t WS_END = WS_PROJ + (size_t)M * DIN * 2;
constexpr int CW_BAR = 4096;

constexpr int RING_OFF = 0, RING_BYTES = 131072;
constexpr int MISC_OFF = RING_BYTES + 320;
constexpr int RST_OFF = RING_BYTES + 8192;
constexpr int PSS_OFF = RING_BYTES + 1024;
constexpr int LBL_OFF = RING_BYTES + 10240;
constexpr int LDS_BYTES = 147456;

#define GAS __attribute__((address_space(1)))
#define LAS __attribute__((address_space(3)))
typedef unsigned short bf16;
typedef unsigned v4u __attribute__((ext_vector_type(4)));
typedef unsigned v2u __attribute__((ext_vector_type(2)));
typedef float f32x4 __attribute__((ext_vector_type(4)));
#define LDS_WAIT() asm volatile("s_waitcnt lgkmcnt(0)" ::: "memory")
#define VM_WAIT() asm volatile("s_waitcnt vmcnt(0)" ::: "memory")
__device__ __forceinline__ unsigned pk2(float lo, float hi) { return pg8::cvt_pk_bf16(lo, hi); }
__device__ __forceinline__ float bf_lo(unsigned w) { return __uint_as_float(w << 16); }
__device__ __forceinline__ float bf_hi(unsigned w) { return __uint_as_float(w & 0xffff0000u); }
__device__ __forceinline__ void unpack8(const v4u r, float (&o)[8]) { o[0] = bf_lo(r.x); o[1] = bf_hi(r.x); o[2] = bf_lo(r.y); o[3] = bf_hi(r.y); o[4] = bf_lo(r.z); o[5] = bf_hi(r.z); o[6] = bf_lo(r.w); o[7] = bf_hi(r.w); }
__device__ __forceinline__ v4u pack8(const float (&o)[8]) { v4u w; w.x = pk2(o[0], o[1]); w.y = pk2(o[2], o[3]); w.z = pk2(o[4], o[5]); w.w = pk2(o[6], o[7]); return w; }
__device__ __forceinline__ float wave_sum(float v) {
#pragma unroll
    for (int o = 1; o < 64; o <<= 1) v += __shfl_xor(v, o);
    return v;
}
__device__ __forceinline__ float sum16(float v) {
#pragma unroll
    for (int o = 1; o < 16; o <<= 1) v += __shfl_xor(v, o);
    return v;
}
#define XB_TMO      128
#define XB_XCNT(j)  (256  + 64 * (j))
#define XB_XSUB(j)  (1280 + 64 * (j))
#define XB_XGEN(j)  (2304 + 64 * (j))
#define XB_TOP      3328
#define XB_TOPGEN   3392
#define XCD_BAR_WORDS 3456
#define XB_SPIN_CAP (1u << 18)

__device__ __forceinline__ unsigned xb_ld(unsigned* p)              { return __hip_atomic_load(p, __ATOMIC_RELAXED, __HIP_MEMORY_SCOPE_AGENT); }
__device__ __forceinline__ unsigned xb_add(unsigned* p, unsigned v) { return __hip_atomic_fetch_add(p, v, __ATOMIC_RELAXED, __HIP_MEMORY_SCOPE_AGENT); }
__device__ __forceinline__ unsigned xb_xcc_id() { return (unsigned)__builtin_amdgcn_s_getreg((3 << 11) | 20) & 0xFu; }
#define XB_SPIN(cond, bar) do { unsigned _sp = 0; while (cond) { __builtin_amdgcn_s_sleep(1); \
    if ((++_sp & 255u) == 0u) { if (xb_ld(&(bar)[XB_TMO])) break; if (_sp > XB_SPIN_CAP) { atomicAdd(&(bar)[XB_TMO], 1u); break; } } } } while (0)

struct XcdBarrier {
    unsigned* bar; unsigned x; int w;
    volatile LAS unsigned* st;
};

__device__ __forceinline__ XcdBarrier xcd_barrier_post(unsigned* bar, volatile LAS unsigned* st, int wave) {
    XcdBarrier b; b.bar = bar; b.x = xb_xcc_id(); b.st = st; b.w = wave;
    if (threadIdx.x == 0) (void)xb_add(&bar[XB_XCNT(b.x)], 1u);
    return b;
}
__device__ __forceinline__ void xcd_barrier_complete(unsigned* bar, unsigned x, unsigned& nloc, unsigned& nx) {
    const unsigned G = gridDim.x * gridDim.y * gridDim.z;
    unsigned sum, cnt, mine, sp = 0u;
    for (;;) {
        sum = 0u; cnt = 0u; mine = 0u;
#pragma unroll
        for (unsigned j = 0; j < 16; ++j) { const unsigned c = xb_ld(&bar[XB_XCNT(j)]); sum += c; cnt += (c > 0u) ? 1u : 0u; }
        if (sum == G) break;
        __builtin_amdgcn_s_sleep(1);
        if ((++sp & 255u) == 0u) { if (xb_ld(&bar[XB_TMO])) break; if (sp > XB_SPIN_CAP) { atomicAdd(&bar[XB_TMO], 1u); break; } }
    }
    mine = xb_ld(&bar[XB_XCNT(x)]);
    nloc = mine > 0u ? mine : 1u; nx = cnt > 0u ? cnt : 1u;
}

__device__ __forceinline__ void xcd_barrier(const XcdBarrier& b) {
    asm volatile("s_waitcnt vmcnt(0)" ::: "memory");
    __syncthreads();
    if (b.w == 0 && fresh_lane() == 0) {
        unsigned* bar = b.bar; asm volatile("" : "+s"(bar));
        __builtin_amdgcn_s_waitcnt(0);
        unsigned nloc = b.st[0], nx = b.st[1];
        if (nloc == 0u) { xcd_barrier_complete(bar, b.x, nloc, nx); b.st[0] = nloc; b.st[1] = nx; }
        const unsigned old = xb_add(&bar[XB_XSUB(b.x)], 1u);
        const unsigned gen = old / nloc;
        if (old + 1u == (gen + 1u) * nloc) {
            __builtin_amdgcn_fence(__ATOMIC_RELEASE, "agent");
            asm volatile("s_waitcnt vmcnt(0)" ::: "memory");
            const unsigned og = xb_add(&bar[XB_TOP], 1u);
            const unsigned tg = og / nx;
            if (og + 1u == (tg + 1u) * nx) xb_add(&bar[XB_TOPGEN], 1u);
            else XB_SPIN(xb_ld(&bar[XB_TOPGEN]) == tg, bar);
            __builtin_amdgcn_fence(__ATOMIC_ACQUIRE, "agent");
            xb_add(&bar[XB_XGEN(b.x)], 1u);
            asm volatile("s_waitcnt vmcnt(0)" ::: "memory");
        } else {
            XB_SPIN(xb_ld(&bar[XB_XGEN(b.x)]) == gen, bar);
            __builtin_amdgcn_fence(__ATOMIC_ACQUIRE, "agent");
            asm volatile("s_waitcnt vmcnt(0)" ::: "memory");
        }
    }
    __syncthreads();
}

__device__ __forceinline__ void transpose_item(const float* W, int K, int N, bf16* WT, int k0, int n0, int drow0, LAS float* scr, int lane, const float* gain) {
    float v[32]; const float* src = W + (size_t)(k0 + (lane >> 5)) * N + n0 + (lane & 31);
#pragma unroll
    for (int i = 0; i < 32; ++i) v[i] = __builtin_nontemporal_load(src + (size_t)(2 * i) * N);
    const float gl = gain ? gain[k0 + lane] : 1.0f;
#pragma unroll
    for (int i = 0; i < 32; ++i) { const float ge = __int_as_float(__builtin_amdgcn_readlane(__float_as_int(gl), 2 * i)), go = __int_as_float(__builtin_amdgcn_readlane(__float_as_int(gl), 2 * i + 1));
        scr[(2 * i + (lane >> 5)) * 33 + (lane & 31)] = v[i] * ((lane >> 5) ? go : ge); }
    LDS_WAIT(); asm volatile("" ::: "memory");
    const int c = lane & 7;
#pragma unroll
    for (int j = 0; j < 4; ++j) { const int n = (lane >> 3) + 8 * j; const LAS float* s = scr + (8 * c) * 33 + n;
        v4u o; o.x = pk2(s[0 * 33], s[1 * 33]); o.y = pk2(s[2 * 33], s[3 * 33]); o.z = pk2(s[4 * 33], s[5 * 33]); o.w = pk2(s[6 * 33], s[7 * 33]);
        __builtin_nontemporal_store(o, (v4u*)(WT + (size_t)(drow0 + n) * K + k0 + 8 * c)); }
    LDS_WAIT(); asm volatile("" ::: "memory");
}
constexpr int W_I_IN = (D / 64) * (DIN / 32), W_PER_LAYER = (D / 64) * (DIN / 32) + (D / 64) * (D / 32) + 2 * (D / 64) * (DFF / 32) + (DFF / 64) * (D / 32);
__device__ __forceinline__ void weights_phase(const float* w_in, const float* w_out, const float* w_gate, const float* w_up, const float* w_down, const float* norm_mix, const float* norm_ffn,
                                              unsigned char* ws, LAS unsigned char* lds, int it0, int it1, int gw, int NGW, int wave, int lane) {
    LAS float* scr = (LAS float*)(lds + RING_OFF + wave * 16384);
    constexpr int I_IN = (D / 64) * (DIN / 32), I_OUT = (D / 64) * (D / 32), I_G = (D / 64) * (DFF / 32), I_DN = (DFF / 64) * (D / 32);
    constexpr int PER_LAYER = W_PER_LAYER;
    for (int it = it0 + gw; it < it1; it += NGW) {
        const int l = it / PER_LAYER; int r = it % PER_LAYER;
        if (r < I_IN) { const int nb = r % (DIN / 32), kb = r / (DIN / 32), n0 = nb * 32, c = (n0 - C_C) & 1023;
            const int drow = (n0 >= C_C && n0 < C_Q) ? C_C + (c >> 7) * 256 + (n0 >= C_H ? 128 : 0) + (c & 127) : n0;
            transpose_item(w_in + (size_t)l * D * DIN, D, DIN, (bf16*)(ws + WS_WIN + l * SZ_WIN), kb * 64, n0, drow, scr, lane, norm_mix + l * D); continue; } r -= I_IN;
        if (r < I_OUT) { const int nb = r % (D / 32), kb = r / (D / 32);
            transpose_item(w_out + (size_t)l * D * D, D, D, (bf16*)(ws + WS_WOUT + l * SZ_WOUT), kb * 64, nb * 32, nb * 32, scr, lane, nullptr); continue; } r -= I_OUT;
        if (r < I_G) { const int nb = r % (DFF / 32), kb = r / (DFF / 32), n0 = nb * 32;
            transpose_item(w_gate + (size_t)l * D * DFF, D, DFF, (bf16*)(ws + WS_WGU + l * SZ_WGU), kb * 64, n0, (n0 >> 7) * 256 + (n0 & 127), scr, lane, norm_ffn + l * D); continue; } r -= I_G;
        if (r < I_G) { const int nb = r % (DFF / 32), kb = r / (DFF / 32), n0 = nb * 32;
            transpose_item(w_up + (size_t)l * D * DFF, D, DFF, (bf16*)(ws + WS_WGU + l * SZ_WGU), kb * 64, n0, (n0 >> 7) * 256 + 128 + (n0 & 127), scr, lane, norm_ffn + l * D); continue; } r -= I_G;
        { const int nb = r % (D / 32), kb = r / (D / 32);
            transpose_item(w_down + (size_t)l * DFF * D, DFF, D, (bf16*)(ws + WS_WDN + l * SZ_WDN), kb * 64, nb * 32, nb * 32, scr, lane, nullptr); }
    }
}
__device__ __forceinline__ void xconv_phase(const float* x_in, bf16* xb, float* ss, const float* lb_logits, float* lbt, int gw, int NGW, int lane, int gtid) {
    for (int m = gw; m < M; m += NGW) {
        const f32x4* xr = (const f32x4*)(x_in + (size_t)m * D) + lane; v2u* o = (v2u*)(xb + (size_t)m * D) + lane; float s = 0.f;
#pragma unroll
        for (int j = 0; j < 8; ++j) { const f32x4 v = xr[64 * j]; v2u w; w.x = pk2(v.x, v.y); w.y = pk2(v.z, v.w); o[64 * j] = w;
            const float a = bf_lo(w.x), b = bf_hi(w.x), c = bf_lo(w.y), d = bf_hi(w.y); s += (a * a + b * b) + (c * c + d * d); }
        s = wave_sum(s);
        if (lane < 8) ss[(size_t)m * 8 + lane] = lane == 0 ? s : 0.f;
    }
    if (gtid < DH) {
        float lg[DEPTH], mx = -3.0e38f;
#pragma unroll
        for (int l = 0; l < DEPTH; ++l) { lg[l] = lb_logits[l * DH + gtid]; mx = fmaxf(mx, lg[l]); }
        float den = 0.f;
#pragma unroll
        for (int l = 0; l < DEPTH; ++l) { lg[l] = __expf(lg[l] - mx); den += lg[l]; }
        float cum = 0.f; const float p0 = lg[0] / den;
#pragma unroll
        for (int l = 0; l < DEPTH; ++l) { cum += lg[l] / den; lbt[l * DH + gtid] = fminf(fmaxf(cum - p0, 0.f), 1.0f - 1e-4f); }
    }
}
__device__ __forceinline__ void final_norm_phase(const bf16* x, const float* gain, float* out, int gw, int NGW, int lane) {
    f32x4 g[8];
#pragma unroll
    for (int j = 0; j < 8; ++j) g[j] = ((const f32x4*)gain)[lane + 64 * j];
    for (int m = gw; m < M; m += NGW) {
        const v2u* xr = (const v2u*)(x + (size_t)m * D) + lane;
        f32x4 v[8]; float s = 0.f;
#pragma unroll
        for (int j = 0; j < 8; ++j) { const v2u w = xr[64 * j]; v[j] = (f32x4){bf_lo(w.x), bf_hi(w.x), bf_lo(w.y), bf_hi(w.y)}; s += (v[j].x * v[j].x + v[j].y * v[j].y) + (v[j].z * v[j].z + v[j].w * v[j].w); }
        const float rs = 1.0f / sqrtf(wave_sum(s) * (1.0f / D) + EPS);
        f32x4* o = (f32x4*)(out + (size_t)m * D) + lane;
#pragma unroll
        for (int j = 0; j < 8; ++j) o[64 * j] = v[j] * rs * g[j];
    }
}
#ifndef CONV_RB
#define CONV_RB 2
#endif
__device__ __forceinline__ void conv_phase(const bf16* proj, const float* cw, const float* gn, bf16* mixed, int gw, int NGW, int lane) {
    constexpr int R = 16, NSTRIP = M / R;
    float w0[2][8], w1[2][8], w2[2][8], gg[2][8];
#pragma unroll
    for (int i = 0; i < 2; ++i)
#pragma unroll
        for (int e = 0; e < 8; ++e) { const int c = i * 512 + lane * 8 + e; w0[i][e] = cw[c]; w1[i][e] = cw[DC + c]; w2[i][e] = cw[2 * DC + c]; gg[i][e] = gn[c]; }
    for (int strip = gw; strip < NSTRIP; strip += NGW) {
        const int m0 = strip * R, t0 = m0 % SEQ;
        float u1[2][8], u2[2][8];
#pragma unroll
        for (int i = 0; i < 2; ++i) {
            if (t0 == 0) {
#pragma unroll
                for (int e = 0; e < 8; ++e) { u1[i][e] = 0.f; u2[i][e] = 0.f; }
            } else {
                const bf16* p1 = proj + (size_t)(m0 - 1) * DIN + i * 512 + lane * 8; const bf16* p2 = p1 - DIN;
                unpack8(*(const v4u*)(p1 + C_U), u1[i]); unpack8(*(const v4u*)(p2 + C_U), u2[i]);
            }
        }
        for (int r = 0; r < R; r += CONV_RB) {
            v4u lb[CONV_RB][2], lu[CONV_RB][2];
#pragma unroll
            for (int k = 0; k < CONV_RB; ++k)
#pragma unroll
                for (int i = 0; i < 2; ++i) { const bf16* p = proj + (size_t)(m0 + r + k) * DIN + i * 512 + lane * 8; lb[k][i] = __builtin_nontemporal_load((const v4u*)(p + C_B)); lu[k][i] = __builtin_nontemporal_load((const v4u*)(p + C_U)); }
#pragma unroll
            for (int k = 0; k < CONV_RB; ++k) {
                const size_t m = (size_t)(m0 + r + k);
#pragma unroll
                for (int i = 0; i < 2; ++i) {
                    float bb[8], uu[8], y[8]; unpack8(lb[k][i], bb); unpack8(lu[k][i], uu);
                    float ss = 0.f;
#pragma unroll
                    for (int e = 0; e < 8; ++e) { const float u0 = uu[e]; y[e] = bb[e] * (w0[i][e] * u2[i][e] + w1[i][e] * u1[i][e] + w2[i][e] * u0); ss += y[e] * y[e]; u2[i][e] = u1[i][e]; u1[i][e] = u0; }
                    const float rs = 1.0f / sqrtf(sum16(ss) * (1.0f / 128.0f) + EPS);
#pragma unroll
                    for (int e = 0; e < 8; ++e) y[e] = y[e] * rs * gg[i][e];
                    *(v4u*)(mixed + m * D + i * 512 + lane * 8) = pack8(y);
                }
            }
        }
    }
}
__device__ __forceinline__ void hgrn_fin_phase(const bf16* proj, const float* gn, bf16* mixed, int gw, int NGW, int lane) {
    float gg[2][8];
#pragma unroll
    for (int i = 0; i < 2; ++i)
#pragma unroll
        for (int e = 0; e < 8; ++e) gg[i][e] = gn[i * 512 + lane * 8 + e];
    for (int m = gw; m < M; m += NGW) {
#pragma unroll
        for (int i = 0; i < 2; ++i) {
            bf16* po = mixed + (size_t)m * D + DC + i * 512 + lane * 8;
            float o[8], g[8]; unpack8(*(const v4u*)po, o); unpack8(*(const v4u*)(proj + (size_t)m * DIN + C_G + i * 512 + lane * 8), g);
            float ss = 0.f;
#pragma unroll
            for (int e = 0; e < 8; ++e) ss += o[e] * o[e];
            const float rs = 1.0f / sqrtf(sum16(ss) * (1.0f / 128.0f) + EPS);
#pragma unroll
            for (int e = 0; e < 8; ++e) o[e] = o[e] * rs * gg[i][e] * g[e];
            *(v4u*)po = pack8(o);
        }
    }
}

#ifndef HG_AUX
#define HG_AUX 2
#endif
typedef short bf16x8_t __attribute__((ext_vector_type(8)));
typedef short s16x4_t __attribute__((ext_vector_type(4)));
typedef short v4i16_t __attribute__((ext_vector_type(4)));
typedef float f32x16 __attribute__((ext_vector_type(16)));
typedef float f32x2_t __attribute__((ext_vector_type(2)));
typedef __bf16 bf16x2_t __attribute__((ext_vector_type(2)));
__device__ __forceinline__ unsigned cvtpk(float lo, float hi) { f32x2_t v = {lo, hi}; bf16x2_t b = __builtin_convertvector(v, bf16x2_t); return __builtin_bit_cast(unsigned, b); }
__device__ __forceinline__ s16x4_t tr_read(const LAS unsigned char* p) { return __builtin_bit_cast(s16x4_t, __builtin_amdgcn_ds_read_tr16_b64_v4i16((LAS v4i16_t*)p)); }
__device__ __forceinline__ constexpr int crow_c(int i, int h) { return (i & 3) + 8 * (i >> 2) + 4 * h; }
#define HG_BAR() do { asm volatile("s_waitcnt lgkmcnt(0)" ::: "memory"); __builtin_amdgcn_s_barrier(); asm volatile("" ::: "memory"); } while (0)
#define MFMA32(a, b, c) __builtin_amdgcn_mfma_f32_32x32x16_bf16((a), (b), (c), 0, 0, 0)
constexpr int HG_RS = 272, HG_TS = 80, HG_VS = 320;
constexpr int HP_QD = 0, HP_K0 = HP_QD + 32 * HG_RS, HP_K0T = HP_K0 + 32 * HG_RS, HP_VN = HP_K0T + 128 * HG_TS, HP_D = HP_VN + 32 * HG_VS, HP_SET = HP_D + 512;
constexpr int HP_TOT = 2 * HP_SET, HP_NRM = HP_TOT + 2 * 4 * 128 * 4, HP_RAW = HP_NRM + 2 * 512, HP_RAWB = 4 * 6144, HP_END = HP_RAW + 2 * HP_RAWB;
static_assert(HP_END <= RING_BYTES && (HP_RAW % 1024) == 0 && (HP_SET % 16) == 0 && (HP_K0T % 16) == 0 && (HP_VN % 16) == 0 && (HP_D % 16) == 0, "HGRN LDS map");
__device__ __forceinline__ bf16x8_t pack_step(const f32x16& x, int s) {
    v4u p; p.x = cvtpk(x[8 * s], x[8 * s + 1]); p.y = cvtpk(x[8 * s + 2], x[8 * s + 3]); p.z = cvtpk(x[8 * s + 4], x[8 * s + 5]); p.w = cvtpk(x[8 * s + 6], x[8 * s + 7]);
    return __builtin_bit_cast(bf16x8_t, p);
}
__device__ __forceinline__ void hg_tr8(const LAS unsigned char* pvt, const LAS unsigned char* pvn, bf16x8_t (&va)[2], bf16x8_t (&vb)[2]) {
    s16x4_t a0, a1, a2, a3, b0, b1, b2, b3;
    asm volatile("ds_read_b64_tr_b16 %0, %8\n\tds_read_b64_tr_b16 %1, %8 offset:%c10\n\tds_read_b64_tr_b16 %2, %8 offset:%c11\n\tds_read_b64_tr_b16 %3, %8 offset:%c12\n\t"
                 "ds_read_b64_tr_b16 %4, %9\n\tds_read_b64_tr_b16 %5, %9 offset:%c13\n\tds_read_b64_tr_b16 %6, %9 offset:%c11\n\tds_read_b64_tr_b16 %7, %9 offset:%c14\n\ts_waitcnt lgkmcnt(0)"
                 : "=&v"(a0), "=&v"(a1), "=&v"(a2), "=&v"(a3), "=&v"(b0), "=&v"(b1), "=&v"(b2), "=&v"(b3)
                 : "v"((unsigned)(size_t)pvt), "v"((unsigned)(size_t)pvn), "i"(8 * HG_VS), "i"(16 * HG_VS), "i"(24 * HG_VS), "i"(4 * HG_VS), "i"(20 * HG_VS) : "memory");
    va[0] = __builtin_shufflevector(a0, a1, 0, 1, 2, 3, 4, 5, 6, 7); va[1] = __builtin_shufflevector(a2, a3, 0, 1, 2, 3, 4, 5, 6, 7);
    vb[0] = __builtin_shufflevector(b0, b1, 0, 1, 2, 3, 4, 5, 6, 7); vb[1] = __builtin_shufflevector(b2, b3, 0, 1, 2, 3, 4, 5, 6, 7);
}
__device__ __forceinline__ void hg_dma_chunk(const bf16* pz, const bf16* pq, const bf16* pv, size_t on, LAS unsigned char* rawb) {
#pragma unroll
    for (int hh = 0; hh < 2; ++hh) {
        __builtin_amdgcn_global_load_lds((const unsigned*)(pz + on + (size_t)(4 * hh) * DIN), (LAS unsigned*)(rawb + 0 * 2048 + hh * 1024), 16, 0, HG_AUX);
        __builtin_amdgcn_global_load_lds((const unsigned*)(pq + on + (size_t)(4 * hh) * DIN), (LAS unsigned*)(rawb + 1 * 2048 + hh * 1024), 16, 0, HG_AUX);
        __builtin_amdgcn_global_load_lds((const unsigned*)(pv + on + (size_t)(4 * hh) * DIN), (LAS unsigned*)(rawb + 2 * 2048 + hh * 1024), 16, 0, HG_AUX);
    }
}
__device__ __forceinline__ void hg_E1(int cn, float (&bl)[8][2], float (&kk)[8][2], float (&qs)[8][2], unsigned (&vcur)[8], const bf16* pz, const bf16* pq, const bf16* pv, LAS unsigned char* lds, int ew, int lane) {
    constexpr int NCH = SEQ / 32;
    LAS unsigned char* rawb = lds + HP_RAW + (cn & 1) * HP_RAWB + ew * 6144;
    asm volatile("s_waitcnt vmcnt(6)" ::: "memory");
    unsigned rz[8], rq[8];
#pragma unroll
    for (int i = 0; i < 8; ++i) { rz[i] = *(const LAS unsigned*)(rawb + 0 * 2048 + i * 256 + 4 * lane); rq[i] = *(const LAS unsigned*)(rawb + 1 * 2048 + i * 256 + 4 * lane); vcur[i] = *(const LAS unsigned*)(rawb + 2 * 2048 + i * 256 + 4 * lane); }
    asm volatile("s_waitcnt lgkmcnt(0)" : "+v"(rz[0]), "+v"(rz[7]), "+v"(rq[0]), "+v"(rq[7]), "+v"(vcur[0]), "+v"(vcur[7]) :: "memory");
    hg_dma_chunk(pz, pq, pv, (size_t)(cn + 2 < NCH ? cn + 2 : cn) * 32 * DIN, rawb);
#pragma unroll
    for (int i = 0; i < 8; ++i) {
#pragma unroll
        for (int e = 0; e < 2; ++e) { const float l2 = e ? bf_hi(rz[i]) : bf_lo(rz[i]); qs[i][e] = e ? bf_hi(rq[i]) : bf_lo(rq[i]);
            kk[i][e] = 1.0f - __builtin_amdgcn_exp2f(l2); bl[i][e] = (i == 0) ? l2 : bl[i - 1][e] + l2; } }
    *(LAS f32x2_t*)(lds + HP_TOT + (cn & 1) * 2048 + (ew * 128 + 2 * lane) * 4) = (f32x2_t){bl[7][0], bl[7][1]};
}
__device__ __forceinline__ void hg_E2(int cn, const float (&bl)[8][2], const float (&kk)[8][2], const float (&qs)[8][2], const unsigned (&vcur)[8], LAS unsigned char* lds, int ew, int lane) {
    const int so = (cn & 1) * HP_SET;
    float off[2] = {0.f, 0.f}, b31[2] = {0.f, 0.f};
#pragma unroll
    for (int w = 0; w < 4; ++w) { const f32x2_t tw = *(const LAS f32x2_t*)(lds + HP_TOT + (cn & 1) * 2048 + (w * 128 + 2 * lane) * 4); if (w < ew) { off[0] += tw.x; off[1] += tw.y; } b31[0] += tw.x; b31[1] += tw.y; }
    unsigned kt0[4], kt1[4];
#pragma unroll
    for (int i = 0; i < 8; ++i) { const int t = 8 * ew + i; float qd[2], k0[2];
#pragma unroll
        for (int e = 0; e < 2; ++e) { const float bt = off[e] + bl[i][e]; qd[e] = qs[i][e] * __builtin_amdgcn_exp2f(bt); k0[e] = kk[i][e] * __builtin_amdgcn_exp2f(fminf(-bt, 115.0f)); }
        *(LAS unsigned*)(lds + so + HP_QD + t * HG_RS + 4 * lane) = cvtpk(qd[0], qd[1]);
        const unsigned kp = cvtpk(k0[0], k0[1]); *(LAS unsigned*)(lds + so + HP_K0 + t * HG_RS + 4 * lane) = kp;
        if ((i & 1) == 0) { kt0[i >> 1] = kp & 0xffffu; kt1[i >> 1] = kp >> 16; } else { kt0[i >> 1] |= kp << 16; kt1[i >> 1] |= kp & 0xffff0000u; }
        *(LAS unsigned*)(lds + so + HP_VN + t * HG_VS + 4 * lane) = vcur[i]; }
    *(LAS v4u*)(lds + so + HP_K0T + (2 * lane) * HG_TS + 16 * ew) = (v4u){kt0[0], kt0[1], kt0[2], kt0[3]};
    *(LAS v4u*)(lds + so + HP_K0T + (2 * lane + 1) * HG_TS + 16 * ew) = (v4u){kt1[0], kt1[1], kt1[2], kt1[3]};
    if (ew == 0) *(LAS f32x2_t*)(lds + so + HP_D + 8 * lane) = (f32x2_t){__builtin_amdgcn_exp2f(b31[0]), __builtin_amdgcn_exp2f(b31[1])};
}
__device__ __forceinline__ void hgrn_chunk_phase(const bf16* proj, const float* gn, bf16* mixed, int nitems, int item0, int istride, LAS unsigned char* lds, int tid, int wave, int lane, unsigned long long& tpa) {
    constexpr int NCH = SEQ / 32; unsigned long long t0_ = 0; (void)t0_;
    const int r = lane & 31, h = lane >> 5, q4 = (lane & 15) >> 2, p4 = lane & 3, g16 = (lane >> 4) & 1;
    for (int item = item0; item < nitems; item += istride) {
        const int b = item >> 3, hd = item & 7;
        if (wave >= 4) {
            const int ew = wave & 3;
            const bf16* pz = proj + (size_t)(b * SEQ + 8 * ew + (lane >> 4)) * DIN + C_Z + hd * HD + 8 * (lane & 15);
            const bf16* pq = proj + (size_t)(b * SEQ + 8 * ew + (lane >> 4)) * DIN + C_Q + hd * HD + 8 * (lane & 15);
            const bf16* pv = proj + (size_t)(b * SEQ + 8 * ew + (lane >> 4)) * DIN + C_I + hd * HD + 8 * (lane & 15);
            asm volatile("s_waitcnt vmcnt(0)" ::: "memory");
            hg_dma_chunk(pz, pq, pv, 0, lds + HP_RAW + ew * 6144);
            hg_dma_chunk(pz, pq, pv, (size_t)32 * DIN, lds + HP_RAW + HP_RAWB + ew * 6144);
            float bl[8][2], kk[8][2], qs[8][2]; unsigned vcur[8];
            hg_E1(0, bl, kk, qs, vcur, pz, pq, pv, lds, ew, lane);
            HG_BAR();
            for (int n = 0; n < NCH; ++n) {
                hg_E2(n, bl, kk, qs, vcur, lds, ew, lane);
                if (n + 1 < NCH) hg_E1(n + 1, bl, kk, qs, vcur, pz, pq, pv, lds, ew, lane);
                HG_BAR();
            }
            asm volatile("s_waitcnt vmcnt(0)" ::: "memory");
            HG_BAR(); HG_BAR();
        } else {
            const int vt = wave;
            f32x16 S0, S1, S2, S3, acc;
#pragma unroll
            for (int i = 0; i < 16; ++i) { S0[i] = 0.f; S1[i] = 0.f; S2[i] = 0.f; S3[i] = 0.f; acc[i] = 0.f; }
            float gnv[4][4];
#pragma unroll
            for (int g = 0; g < 4; ++g)
#pragma unroll
                for (int j = 0; j < 4; ++j) gnv[g][j] = gn[hd * HD + vt * 32 + 8 * g + 4 * h + j];
            const bf16* pg = proj + (size_t)(b * SEQ + r) * DIN + C_G + hd * HD + vt * 32 + 4 * h;
            f32x16 accp;
#pragma unroll
            for (int i = 0; i < 16; ++i) accp[i] = 0.f;
            HG_BAR();
            for (int n = 0; n < NCH + 2; ++n) {
                const int cm = n - 1, cf = n - 2;
                v2u rg[4];
#pragma unroll
                for (int g = 0; g < 4; ++g) rg[g] = *(const v2u*)(pg + (size_t)(cf >= 0 ? cf : 0) * 32 * DIN + 8 * g);
#pragma unroll
                for (int i = 0; i < 16; ++i) accp[i] = acc[i];
                if (cm >= 0 && cm < NCH) {
                const LAS unsigned char* base = lds + (cm & 1) * HP_SET;
                f32x16 X;
#pragma unroll
                for (int i = 0; i < 16; ++i) { X[i] = 0.f; acc[i] = 0.f; }
                {
                    const LAS unsigned char* pa_k = base + HP_K0 + r * HG_RS + 16 * h; const LAS unsigned char* pb_q = base + HP_QD + r * HG_RS + 16 * h;
                    bf16x8_t ka[8], qb[8];
#pragma unroll
                    for (int ks = 0; ks < 8; ++ks) { ka[ks] = *(const LAS bf16x8_t*)(pa_k + 32 * ks); qb[ks] = *(const LAS bf16x8_t*)(pb_q + 32 * ks); }
#pragma unroll
                    for (int ks = 0; ks < 8; ++ks) X = MFMA32(ka[ks], qb[ks], X);
                }
                {
                    const LAS unsigned char* pq2 = base + HP_QD + r * HG_RS + 8 * h;
                    s16x4_t ql[2][4], qh[2][4];
#pragma unroll
                    for (int s2 = 0; s2 < 2; ++s2)
#pragma unroll
                        for (int kt = 0; kt < 4; ++kt) { ql[s2][kt] = *(const LAS s16x4_t*)(pq2 + (kt * 32 + 16 * s2) * 2); qh[s2][kt] = *(const LAS s16x4_t*)(pq2 + (kt * 32 + 16 * s2 + 8) * 2); }
#pragma unroll
                    for (int s2 = 0; s2 < 2; ++s2) {
                        acc = MFMA32(pack_step(S0, s2), __builtin_shufflevector(ql[s2][0], qh[s2][0], 0, 1, 2, 3, 4, 5, 6, 7), acc);
                        acc = MFMA32(pack_step(S1, s2), __builtin_shufflevector(ql[s2][1], qh[s2][1], 0, 1, 2, 3, 4, 5, 6, 7), acc);
                        acc = MFMA32(pack_step(S2, s2), __builtin_shufflevector(ql[s2][2], qh[s2][2], 0, 1, 2, 3, 4, 5, 6, 7), acc);
                        acc = MFMA32(pack_step(S3, s2), __builtin_shufflevector(ql[s2][3], qh[s2][3], 0, 1, 2, 3, 4, 5, 6, 7), acc);
                    }
                }
#pragma unroll
                for (int i = 0; i < 16; ++i) if (crow_c(i, h) > r) X[i] = 0.f;
                const LAS unsigned char* pvt = base + HP_VN + (4 * h + q4) * HG_VS + (vt * 32 + g16 * 16 + p4 * 4) * 2;
                const LAS unsigned char* pvn = base + HP_VN + (8 * h + q4) * HG_VS + (vt * 32 + g16 * 16 + p4 * 4) * 2;
                const LAS unsigned char* pa = base + HP_K0T + r * HG_TS + 16 * h;
                bf16x8_t va[2], vb[2], kf[2][4];
                hg_tr8(pvt, pvn, va, vb);
#pragma unroll
                for (int s2 = 0; s2 < 2; ++s2)
#pragma unroll
                    for (int kt = 0; kt < 4; ++kt) kf[s2][kt] = *(const LAS bf16x8_t*)(pa + (kt * 32) * HG_TS + 32 * s2);
#pragma unroll
                for (int s2 = 0; s2 < 2; ++s2) acc = MFMA32(va[s2], pack_step(X, s2), acc);
#pragma unroll
                for (int ks = 0; ks < 2; ++ks) { S0 = MFMA32(kf[ks][0], vb[ks], S0); S1 = MFMA32(kf[ks][1], vb[ks], S1); S2 = MFMA32(kf[ks][2], vb[ks], S2); S3 = MFMA32(kf[ks][3], vb[ks], S3); }
                {
                    float ssq = 0.f;
#pragma unroll
                    for (int i = 0; i < 16; ++i) ssq += acc[i] * acc[i];
                    ssq += __shfl_xor(ssq, 32);
                    if (h == 0) *(LAS float*)(lds + HP_NRM + (cm & 1) * 512 + (r * 4 + vt) * 4) = ssq;
                }
                {
                    const LAS unsigned char* pd = base + HP_D + (4 * h) * 4;
#pragma unroll
                    for (int g = 0; g < 4; ++g) { const f32x4 d0 = *(const LAS f32x4*)(pd + (0 * 32 + 8 * g) * 4), d1 = *(const LAS f32x4*)(pd + (1 * 32 + 8 * g) * 4), d2 = *(const LAS f32x4*)(pd + (2 * 32 + 8 * g) * 4), d3 = *(const LAS f32x4*)(pd + (3 * 32 + 8 * g) * 4);
#pragma unroll
                        for (int j = 0; j < 4; ++j) { S0[4 * g + j] *= d0[j]; S1[4 * g + j] *= d1[j]; S2[4 * g + j] *= d2[j]; S3[4 * g + j] *= d3[j]; } }
                }
                }
                if (cf >= 0) {
                {
                    const f32x4 pn = *(const LAS f32x4*)(lds + HP_NRM + (cf & 1) * 512 + r * 16);
                    const float rs = 1.0f / sqrtf(((pn[0] + pn[1]) + (pn[2] + pn[3])) * (1.0f / 128.0f) + EPS);
                    bf16* po = mixed + (size_t)(b * SEQ + cf * 32 + r) * D + DC + hd * HD + vt * 32 + 4 * h;
#pragma unroll
                    for (int g = 0; g < 4; ++g) { const float g0 = bf_lo(rg[g].x), g1 = bf_hi(rg[g].x), g2 = bf_lo(rg[g].y), g3 = bf_hi(rg[g].y);
                        *(v2u*)(po + 8 * g) = (v2u){cvtpk(accp[4 * g] * rs * gnv[g][0] * g0, accp[4 * g + 1] * rs * gnv[g][1] * g1), cvtpk(accp[4 * g + 2] * rs * gnv[g][2] * g2, accp[4 * g + 3] * rs * gnv[g][3] * g3)}; }
                }
                }
                HG_BAR();
            }
        }
        HG_BAR();
    }
}

#ifndef DUP_GOUT
#define DUP_GOUT 0
#endif
#ifndef DUP_NORM
#define DUP_NORM 0
#endif
#ifndef DUP_GIN
#define DUP_GIN 0
#endif
#ifndef DUP_REC
#define DUP_REC 0
#endif
#ifndef DUP_CONV
#define DUP_CONV 0
#endif
#ifndef DUP_GGU
#define DUP_GGU 0
#endif
#ifndef DUP_PRO
#define DUP_PRO 0
#endif
__device__ __forceinline__ void stagger(int bx, int ng, int dticks) {
    const int g = (bx >> 3) % ng; if (g == 0 || dticks == 0) return;
    const unsigned long long t0 = __builtin_amdgcn_s_memrealtime(), dt = (unsigned long long)(g * dticks);
    while (__builtin_amdgcn_s_memrealtime() - t0 < dt) __builtin_amdgcn_s_sleep(8);
}
#ifndef STG_NG
#define STG_NG 4
#endif
#ifndef STG_IN
#define STG_IN 0
#endif
#ifndef STG_OUT
#define STG_OUT 0
#endif
#ifndef STG_GU
#define STG_GU 0
#endif
#ifndef STG_DN
#define STG_DN 0
#endif
struct FixedOrder { int n;
    __device__ bool next(int i, pg8::Unit& u) const { if (i >= n) return false; u.pm = 0; u.pn = 0; return true; }
    __device__ __forceinline__ void a_ready(const pg8::Unit&) const {}
    __device__ __forceinline__ void done(const pg8::Unit&) const {} };
#ifndef DYN_ROLES
#define DYN_ROLES 0
#endif
#ifndef W_IN_MIX
#define W_IN_MIX 1
#endif
#ifndef PROBE_HALF
#define PROBE_HALF 0
#endif
#ifndef PROBE_FIXED
#define PROBE_FIXED 0
#endif
#ifndef TPROBE
#define TPROBE 0
#endif
#ifndef TP_BLOCK
#define TP_BLOCK 0
#endif
#ifndef TP_MAG
#define TP_MAG 4
#endif
#define TP_B(k) do { if (TPROBE == (k)) tp_t0 = __builtin_amdgcn_s_memrealtime(); } while (0)
#define TP_E(k) do { if (TPROBE == (k)) tp_acc += __builtin_amdgcn_s_memrealtime() - tp_t0; } while (0)
struct Args { const float* in[13]; float* out; unsigned char* ws; int ph_lo, ph_hi; };
__global__ void __launch_bounds__(NTHR, 2) fwd(Args args) {
    extern __shared__ __attribute__((aligned(16))) unsigned char lds_raw[];
    LAS unsigned char* lds = (LAS unsigned char*)lds_raw;
    volatile LAS unsigned* MISC = (volatile LAS unsigned*)(lds + MISC_OFF);
    const int wave_k = __builtin_amdgcn_readfirstlane(threadIdx.x >> 6), wave = wave_k;
    const int G = gridDim.x, bx = blockIdx.x, vcu = (G % 8 == 0) ? (bx % 8) * (G / 8) + bx / 8 : bx;
    const int gw = vcu * NWAVES + wave, NGW = G * NWAVES;
    unsigned char* ws = args.ws;
    unsigned* ctl = (unsigned*)(ws + WS_CTL);
    if (threadIdx.x < 32) MISC[threadIdx.x] = 0u;
    __syncthreads();
#if MK_ONE_LAUNCH
    XcdBarrier bar = xcd_barrier_post(ctl + CW_BAR, MISC + 8, wave);
#ifndef TP_BARSEL
#define TP_BARSEL -1
#endif
#define GRID_BAR(k) do { const bool tpsel = TP_BARSEL < 0 || ((k) == 0 ? 0 : ((k) - 1) % 5 + 1) == TP_BARSEL; if (tpsel) TP_B(1); xcd_barrier(bar); if (tpsel) TP_E(1); } while (0)
#else
#define GRID_BAR(k) do { } while (0)
#endif
    const float* x_in = args.in[0]; const float* norm_mix = args.in[1]; const float* w_in = args.in[2]; const float* conv_w = args.in[3]; const float* gn_conv = args.in[4];
    const float* lb_logits = args.in[5]; const float* gn_hgrn = args.in[6]; const float* w_out = args.in[7]; const float* norm_ffn = args.in[8];
    const float* w_gate = args.in[9]; const float* w_up = args.in[10]; const float* w_down = args.in[11]; const float* norm_final = args.in[12];
    float* out = args.out;
    bf16* HB = (bf16*)(ws + WS_HB); bf16* PROJ = (bf16*)(ws + WS_PROJ);
    const float* LBT = (const float*)(ws + WS_LB);
    const int lo = args.ph_lo, hi = args.ph_hi; (void)lo; (void)hi;
    unsigned long long tp_t0 = 0, tp_acc = 0; (void)tp_t0; (void)tp_acc;
#if MK_ONE_LAUNCH
#define IN(k) true
#else
#define IN(k) (lo <= (k) && (k) < hi)
#endif
#define SEAM(k) do { if (IN((k) + 1)) GRID_BAR(k); } while (0)

    bf16* XB = (bf16*)((unsigned char*)out + (size_t)M * D * 2);
    float* SS = (float*)(ws + WS_SS);
    unsigned long long* ARR = (unsigned long long*)(ctl + 16384);
    LAS float* PSS = (LAS float*)(lds + PSS_OFF); LAS float* RST = (LAS float*)(lds + RST_OFF);
    if (IN(0)) { TP_B(10); const int lane = fresh_lane(), gtid = vcu * NTHR + wave * 64 + lane;
        weights_phase(w_in, w_out, w_gate, w_up, w_down, norm_mix, norm_ffn, ws, lds, 0, W_IN_MIX ? W_I_IN : DEPTH * W_PER_LAYER, gw, NGW, wave, lane);
        xconv_phase(x_in, XB, SS, lb_logits, (float*)(ws + WS_LB), gw, NGW, lane, gtid);
        TP_E(10); SEAM(0); }
    for (int l = 0; l < DEPTH; ++l) {
        const int p = 1 + 5 * l;
        int bxl = blockIdx.x, Gl = gridDim.x, wvl = wave_k; asm volatile("" : "+s"(bxl), "+s"(Gl), "+s"(wvl));
        const int bx = bxl, G = Gl, wave = wvl & 7;
        if (IN(p + 0)) {
            TP_B(4);
            pg8::Gemm g{XB, (const bf16*)(ws + WS_WIN + l * SZ_WIN), M, DIN, D}; pg8::StaticOrder S; S.init(M, DIN, G, bx); pg8::EpiProj E{PROJ, DIN, (const LAS float*)(lds + LBL_OFF), SS, RST};
            { const int t = wave * 64 + fresh_lane(); LAS float* LBL = (LAS float*)(lds + LBL_OFF); LBL[t] = LBT[l * DH + t]; LBL[t + 512] = LBT[l * DH + t + 512]; }
            if (wave == 0 && fresh_lane() == 0) RST[0] = 0.f; __syncthreads();
            pg8::gemm_phase<pg8::EpiProj, pg8::StaticOrder, PG8_ALIGNV, PG8_SP2V>(lds + RING_OFF, g, S, E, tp_acc, wave);
#if PROBE_FIXED
            {
                const bool active = PROBE_HALF == 0 ? true : (PROBE_HALF == 1 ? (bx & 7) < 4 : ((bx >> 3) & 1) == 0);
                if (active) { pg8::StaticOrder S2; S2.init(M, DIN, G, bx); S2.fixed = 14; pg8::EpiProj E2{(bf16*)(ws + WS_END) + (size_t)bx * 65536, 256, (const LAS float*)(lds + LBL_OFF), SS, RST};
                    pg8::gemm_phase<pg8::EpiProj, pg8::StaticOrder, PG8_ALIGNV, PG8_SP2V>(lds + RING_OFF, g, S2, E2, tp_acc, wave); } }
#endif
            if (DYN_ROLES && wave == 0 && fresh_lane() == 0) (void)__hip_atomic_fetch_max(ARR + l * 8 + (bx & 7), (unsigned long long)__builtin_amdgcn_s_memrealtime(), __ATOMIC_RELAXED, __HIP_MEMORY_SCOPE_AGENT);
            TP_E(4); SEAM(p + 0); }
        if (IN(p + 1)) {
            bool role_h; int idx; const int lane = fresh_lane(), tid = wave * 64 + lane;
            if (DYN_ROLES && G == 256) {
                if (tid == 0) { unsigned long long t[8];
#pragma unroll
                    for (int j = 0; j < 8; ++j) t[j] = __hip_atomic_load(ARR + l * 8 + j, __ATOMIC_RELAXED, __HIP_MEMORY_SCOPE_AGENT);
                    const int me = bx & 7; int rk = 0; unsigned long long tme = 0;
#pragma unroll
                    for (int j = 0; j < 8; ++j) tme = (j == me) ? t[j] : tme;
#pragma unroll
                    for (int j = 0; j < 8; ++j) rk += (t[j] < tme || (t[j] == tme && j < me)) ? 1 : 0;
                    MISC[20] = (unsigned)rk; }
                __syncthreads();
                const int rk = (int)MISC[20]; role_h = rk < 4; idx = (rk & 3) * 32 + (bx >> 3);
            } else { role_h = ((bx >> 3) & 1) == 0; idx = (bx & 7) + 8 * (bx >> 4); }
            if (role_h) { unsigned long long c40 = 0; if (TPROBE == 40) c40 = __builtin_amdgcn_s_memtime(); TP_B(7); hgrn_chunk_phase(PROJ, gn_hgrn + l * DH, HB, BATCH * HEADS, idx, G >> 1, lds + RING_OFF, tid, wave, lane, tp_acc); TP_E(7); if (TPROBE == 40) tp_acc += (__builtin_amdgcn_s_memtime() - c40) / 10; }
            else { TP_B(8); const int gwc = ((DYN_ROLES && G == 256) ? idx : (idx & 7) * (G >> 4) + (idx >> 3)) * NWAVES + wave, ngwc = (G >> 1) * NWAVES;
                conv_phase(PROJ, conv_w + l * 3 * DC, gn_conv + l * DC, HB, gwc, ngwc, lane);
                TP_E(8); TP_B(9);
                if (W_IN_MIX) { const int e = (l + 1) * W_PER_LAYER + W_I_IN;
                    weights_phase(w_in, w_out, w_gate, w_up, w_down, norm_mix, norm_ffn, ws, lds, l * W_PER_LAYER + W_I_IN, e < DEPTH * W_PER_LAYER ? e : DEPTH * W_PER_LAYER, gwc, ngwc, wave, lane); }
                TP_E(9); }
            SEAM(p + 1); }
        if (IN(p + 2)) {
            TP_B(3);
            pg8::Gemm g{HB, (const bf16*)(ws + WS_WOUT + l * SZ_WOUT), M, D, D}; pg8::StaticOrder S; S.init(M, D, G, bx); pg8::EpiResBf16 E{XB, XB, D, SS, PSS};
            pg8::gemm_phase<pg8::EpiResBf16, pg8::StaticOrder, true, PG8_SP2V>(lds + RING_OFF, g, S, E, tp_acc, wave);
            TP_E(3); SEAM(p + 2); }
        unsigned long long c41 = 0;
        if (IN(p + 3)) {
            TP_B(5); if (TPROBE == 41) c41 = __builtin_amdgcn_s_memtime();
            pg8::Gemm g{XB, (const bf16*)(ws + WS_WGU + l * SZ_WGU), M, NGU, D}; pg8::StaticOrder S; S.init(M, NGU, G, bx); pg8::EpiSwiGLU E{PROJ, DFF, SS, RST};
            if (wave == 0 && fresh_lane() == 0) RST[0] = 0.f; __syncthreads();
            pg8::gemm_phase<pg8::EpiSwiGLU, pg8::StaticOrder, PG8_ALIGNV, PG8_SP2V>(lds + RING_OFF, g, S, E, tp_acc, wave);
            TP_E(5); if (TPROBE == 41) tp_acc += (__builtin_amdgcn_s_memtime() - c41) / 10; SEAM(p + 3); }
        if (IN(p + 4)) {
            TP_B(2);
            pg8::Gemm g{PROJ, (const bf16*)(ws + WS_WDN + l * SZ_WDN), M, D, DFF}; pg8::StaticOrder S; S.init(M, D, G, bx); pg8::EpiResBf16 E{XB, l == DEPTH - 1 ? HB : XB, D, SS, PSS};
            pg8::gemm_phase<pg8::EpiResBf16, pg8::StaticOrder, true, PG8_SP2V>(lds + RING_OFF, g, S, E, tp_acc, wave);
            TP_E(2); SEAM(p + 4); }
    }
    if (IN(NPH - 1)) { TP_B(11); const int lane = fresh_lane(); final_norm_phase(HB, norm_final, out, gw, NGW, lane); TP_E(11); }
#if TPROBE
    if (bx == TP_BLOCK && (int)threadIdx.x == ((TPROBE >= 33 && TPROBE <= 36) ? 256 : 0)) { const unsigned long long t0 = __builtin_amdgcn_s_memrealtime(), dt = tp_acc * TP_MAG; while (__builtin_amdgcn_s_memrealtime() - t0 < dt) __builtin_amdgcn_s_sleep(16); }
#endif
#undef IN
#undef SEAM
}

extern "C" void kernel_launch(void* const* d_in, const int* in_sizes, int n_in, void* d_out, int out_size, void* d_ws, size_t ws_size, hipStream_t stream) {
    static int grid = 0;
    if (grid == 0) {
        if (n_in != 13 || in_sizes[0] != M * D || out_size != M * D || ws_size < WS_END) { fprintf(stderr, "kernel_launch: unexpected shapes (n_in %d, in0 %d, out %d, ws %zu < %zu); nothing launched\n", n_in, n_in > 0 ? in_sizes[0] : -1, out_size, ws_size, (size_t)WS_END); grid = -1; return; }
        int dev = 0, cus = 0;
        if (hipGetDevice(&dev) != hipSuccess || hipDeviceGetAttribute(&cus, hipDeviceAttributeMultiprocessorCount, dev) != hipSuccess) { grid = -1; return; }
        if (hipFuncSetAttribute((const void*)fwd, hipFuncAttributeMaxDynamicSharedMemorySize, LDS_BYTES) != hipSuccess) { fprintf(stderr, "kernel_launch: hipFuncSetAttribute failed\n"); grid = -1; return; }
        (void)hipGetLastError();
        grid = cus;
    }
    if (grid < 0) return;
    (void)hipMemsetAsync((char*)d_ws + WS_CTL, 0, CTL_ZERO_BYTES, stream);
    Args a{};
    for (int i = 0; i < 13; ++i) a.in[i] = (const float*)d_in[i];
    a.out = (float*)d_out; a.ws = (unsigned char*)d_ws;
#if MK_ONE_LAUNCH
    a.ph_lo = 0; a.ph_hi = NPH;
    hipLaunchKernelGGL(fwd, dim3(grid), dim3(NTHR), LDS_BYTES, stream, a);
#else
    for (int p = 0; p < NPH; ++p) { a.ph_lo = p; a.ph_hi = p + 1; hipLaunchKernelGGL(fwd, dim3(grid), dim3(NTHR), LDS_BYTES, stream, a); }
#endif
}
```
